# Optimizing an MI355X kernel written in HIP

```python
import math
import jax, jax.numpy as jnp
from jax import lax
import numpy as np

D_MODEL = 1024
BATCH = 32
SEQ = 2048
DEPTH = 2

CTX_LEN = 256
GRID_W = 64
D_MIX = D_MODEL
NORM_EPS = 1e-6
A_WIDTH = D_MIX // 4
A_GROUPS = 4
A_CHUNK = 128
A_LN_EPS = 1e-5
B_HEADS = 4
B_HEAD_DIM = D_MIX // 16
B_WIDTH = B_HEADS * 2 * B_HEAD_DIM
B_QBLOCK = 128
ROPE_THETA = 10000.0
C_HEADS = 4
C_HEAD_DIM = D_MIX // 16
C_WIDTH = C_HEADS * C_HEAD_DIM
C_CONV = 5
C_CHUNK = 64
IN_SPLITS = [A_WIDTH] * 3 + [B_WIDTH] * 4 + [C_WIDTH] * 4 + [C_HEADS] * 4
D_IN = sum(IN_SPLITS)
IN_OFFSETS = [int(o) for o in np.cumsum(IN_SPLITS)[:-1]]

kernel_name = 'hybrid_gmlp_diffattn_gdn_prefix_block'


def rms_norm(x, w, eps=NORM_EPS):
    xf = x.astype(jnp.float32)
    y = xf * lax.rsqrt(jnp.mean(xf * xf, axis=-1, keepdims=True) + eps)
    return (y * w.astype(jnp.float32)).astype(x.dtype)


def layer_norm(x, w, eps=A_LN_EPS):
    xf = x.astype(jnp.float32)
    xc = xf - jnp.mean(xf, axis=-1, keepdims=True)
    y = xc * lax.rsqrt(jnp.mean(xc * xc, axis=-1, keepdims=True) + eps)
    return (y * w.astype(jnp.float32)).astype(x.dtype)


def l2_norm(x, eps=1e-6):
    xf = x.astype(jnp.float32)
    return (xf * lax.rsqrt(jnp.sum(xf * xf, axis=-1, keepdims=True) + eps)).astype(x.dtype)


def split_cols(p):
    return jnp.split(p, IN_OFFSETS, axis=-1)


def chunk_mlp(u, v, z, ln_w, w_s, b_s):
    bsz, n, _ = u.shape
    vc = layer_norm(v, ln_w).reshape(bsz, n // A_CHUNK, A_CHUNK, A_GROUPS, A_WIDTH // A_GROUPS)
    s = jnp.einsum('gij,bcjgd->bcigd', w_s, vc) + b_s.T[None, None, :, :, None]
    return u * s.reshape(bsz, n, A_WIDTH) * jax.nn.silu(z)


def rope_1d(x, pos):
    n = x.shape[-1]
    inv_freq = ROPE_THETA ** (-jnp.arange(0, n, 2, dtype=jnp.float32) / n)
    ang = pos.astype(jnp.float32)[:, None] * inv_freq[None, :]
    ang = jnp.concatenate([ang, ang], axis=-1)[None, :, None, :]
    x1, x2 = x[..., : n // 2], x[..., n // 2:]
    rot = jnp.concatenate([-x2, x1], axis=-1)
    return x * jnp.cos(ang).astype(x.dtype) + rot * jnp.sin(ang).astype(x.dtype)


def rope_2d(x, rows, cols):
    half = x.shape[-1] // 2
    return jnp.concatenate([rope_1d(x[..., :half], rows), rope_1d(x[..., half:], cols)], axis=-1)


def diff_attn_core(q, k, v, lam):
    s = jnp.einsum('bqhd,bkhd->bhqk', q, k, preferred_element_type=jnp.float32) * (q.shape[-1] ** -0.5)
    p = jax.nn.softmax(s, axis=-1)
    bsz, _, nq, nk = p.shape
    p = p.reshape(bsz, B_HEADS, 2, nq, nk)
    p = p[:, :, 0] - lam * p[:, :, 1]
    return jnp.einsum('bhqk,bkhe->bqhe', p.astype(v.dtype), v)


def diff_attn_latent(q, k_all, v_all, lam):
    bsz, n, h2, d = q.shape
    nb = n // B_QBLOCK
    qb = q.reshape(bsz, nb, B_QBLOCK, h2, d).transpose(1, 0, 2, 3, 4)
    out = lax.map(lambda qi: diff_attn_core(qi, k_all, v_all, lam), qb)
    return out.transpose(1, 0, 2, 3, 4).reshape(bsz, n, B_HEADS, 2 * B_HEAD_DIM)


def short_conv(x, w):
    n = x.shape[1]
    pad = C_CONV // 2
    xp = jnp.pad(x, ((0, 0), (pad, pad), (0, 0)))
    out = xp[:, 0:n] * w[0]
    for j in range(1, C_CONV):
        out = out + xp[:, j:j + n] * w[j]
    return out


def gated_delta_chunked(q, k, v, g, beta, state):
    f32 = jnp.float32
    bsz, n, h, dk = q.shape
    dv = v.shape[-1]
    nc = n // C_CHUNK

    def chunks(t):
        t = t.astype(f32).reshape((bsz, nc, C_CHUNK, h) + t.shape[3:])
        return jnp.moveaxis(t, (1, 3), (0, 2))

    qc = chunks(q) * (dk ** -0.5)
    kc = chunks(k)
    vc = chunks(v)
    gc = jnp.cumsum(chunks(g), axis=-1)
    bc = chunks(beta)
    tril = jnp.tril(jnp.ones((C_CHUNK, C_CHUNK), dtype=bool))
    strict = jnp.tril(jnp.ones((C_CHUNK, C_CHUNK), dtype=bool), -1)
    diff = gc[..., :, None] - gc[..., None, :]
    decay = jnp.where(tril, jnp.exp(jnp.where(tril, diff, 0.0)), 0.0)
    kb = kc * bc[..., None]
    lmat = jnp.where(strict, jnp.einsum('...id,...jd->...ij', kb, kc) * decay, 0.0)
    eye = jnp.eye(C_CHUNK, dtype=f32)
    tmat = lax.linalg.triangular_solve(lmat + eye, jnp.broadcast_to(eye, lmat.shape),
                                       left_side=True, lower=True, unit_diagonal=True)
    u = tmat @ (vc * bc[..., None])
    w = tmat @ (kb * jnp.exp(gc)[..., None])
    attn = jnp.where(tril, jnp.einsum('...id,...jd->...ij', qc, kc) * decay, 0.0)
    q_dec = qc * jnp.exp(gc)[..., None]
    g_last = gc[..., -1]
    k_dec = kc * jnp.exp(g_last[..., None] - gc)[..., None]

    def step(s, xs):
        q_i, k_i, u_i, w_i, a_i, gl_i = xs
        v_new = u_i - w_i @ s
        o_i = q_i @ s + a_i @ v_new
        s = s * jnp.exp(gl_i)[..., None, None] + jnp.swapaxes(k_i, -1, -2) @ v_new
        return s, o_i

    s_fin, o = lax.scan(step, state.astype(f32), (q_dec, k_dec, u, w, attn, g_last))
    o = jnp.moveaxis(o, (0, 2), (1, 3)).reshape(bsz, n, h, dv)
    return o.astype(v.dtype), s_fin


def gdn_prep(q, k, v, b_f, b_b, a_f, a_b, conv_w, a_log, dt_bias):
    f32 = jnp.float32
    bsz, n, _ = q.shape
    qkv = jax.nn.silu(short_conv(jnp.concatenate([q, k, v], axis=-1), conv_w))
    q, k, v = jnp.split(qkv, 3, axis=-1)
    hs = lambda t: t.reshape(bsz, n, C_HEADS, C_HEAD_DIM)
    q, k, v = l2_norm(hs(q)), l2_norm(hs(k)), hs(v)
    dirs = []
    for d, (b, a) in enumerate(((b_f, a_f), (b_b, a_b))):
        beta = jax.nn.sigmoid(b.astype(f32))
        g = -jnp.exp(a_log[d].astype(f32)) * jax.nn.softplus(a.astype(f32) + dt_bias[d].astype(f32))
        dirs.append((g, beta))
    return q, k, v, dirs


def hybrid_layer(x, xc, c_act, cc_act, w_ada, b_ada, norm_w, w_in, w_out,
                 a_ln_w, a_ws, a_bs, b_lam, b_subln_w,
                 c_conv_w, c_a_log, c_dt_bias, c_norm_w,
                 rows, cols, layer_idx, ctx_out):
    bsz, n, _ = x.shape
    shift, scale, gate = jnp.split((c_act @ w_ada + b_ada)[:, None, :], 3, axis=-1)
    shift_c, scale_c, gate_c = jnp.split(cc_act @ w_ada + b_ada, 3, axis=-1)
    h = rms_norm(x, norm_w) * (1.0 + scale) + shift
    hc = rms_norm(xc, norm_w) * (1.0 + scale_c) + shift_c
    pa = split_cols(h @ w_in)
    pc = split_cols(hc @ w_in)

    y_a = chunk_mlp(pa[0], pa[1], pa[2], a_ln_w, a_ws, a_bs)

    lam_init = 0.8 - 0.6 * math.exp(-0.3 * layer_idx)
    lf = b_lam.astype(jnp.float32)
    lam = jnp.exp(jnp.sum(lf[0] * lf[1])) - jnp.exp(jnp.sum(lf[2] * lf[3])) + lam_init

    def heads(q, k, v):
        m = q.shape[1]
        return (q.reshape(bsz, m, 2 * B_HEADS, B_HEAD_DIM), k.reshape(bsz, m, 2 * B_HEADS, B_HEAD_DIM),
                v.reshape(bsz, m, B_HEADS, 2 * B_HEAD_DIM))

    def finish_b(o, z):
        o = rms_norm(o, b_subln_w) * (1.0 - lam_init)
        return o.reshape(o.shape[0], o.shape[1], B_WIDTH) * jax.nn.silu(z)

    q_l, k_l, v_l = heads(pa[3], pa[4], pa[5])
    q_l, k_l = rope_2d(q_l, rows, cols), rope_2d(k_l, rows, cols)
    q_c, k_c, v_c = heads(pc[3], pc[4], pc[5])
    k_all = jnp.concatenate([k_c, k_l], axis=1)
    v_all = jnp.concatenate([v_c, v_l], axis=1)
    y_b = finish_b(diff_attn_latent(q_l, k_all, v_all, lam), pa[6])

    lat = gdn_prep(pa[7], pa[8], pa[9], pa[11], pa[12], pa[13], pa[14], c_conv_w, c_a_log, c_dt_bias)
    cxt = gdn_prep(pc[7], pc[8], pc[9], pc[11], pc[12], pc[13], pc[14], c_conv_w, c_a_log, c_dt_bias)
    zero = jnp.zeros((bsz, C_HEADS, C_HEAD_DIM, C_HEAD_DIM), jnp.float32)
    o_lat, o_ctx = [], []
    for d in range(2):
        fl = (lambda t: jnp.flip(t, axis=1)) if d == 1 else (lambda t: t)
        ql, kl, vl, dl = lat
        qc_, kc_, vc_, dc = cxt
        oc, s_c = gated_delta_chunked(fl(qc_), fl(kc_), fl(vc_), fl(dc[d][0]), fl(dc[d][1]), zero)
        ol, _ = gated_delta_chunked(fl(ql), fl(kl), fl(vl), fl(dl[d][0]), fl(dl[d][1]), s_c)
        o_lat.append(fl(ol))
        o_ctx.append(fl(oc))

    def finish_c(o, z):
        o = rms_norm(o, c_norm_w)
        return o.reshape(o.shape[0], o.shape[1], C_WIDTH) * jax.nn.silu(z)

    y_c = finish_c(o_lat[0] + o_lat[1], pa[10])

    x = x + gate * (jnp.concatenate([y_a, y_b, y_c], axis=-1) @ w_out)
    if ctx_out:
        yc_a = chunk_mlp(pc[0], pc[1], pc[2], a_ln_w, a_ws, a_bs)
        yc_b = finish_b(diff_attn_core(q_c, k_c, v_c, lam), pc[6])
        yc_c = finish_c(o_ctx[0] + o_ctx[1], pc[10])
        xc = xc + gate_c * (jnp.concatenate([yc_a, yc_b, yc_c], axis=-1) @ w_out)
    return x, xc


def setup_inputs(seed: int = 0) -> dict:
    key = jax.random.key(seed)
    ks = jax.random.split(key, 20)
    f32 = jnp.float32
    nrm = lambda k, s: jax.random.normal(k, s, dtype=f32)
    dt = jnp.exp(jax.random.uniform(ks[17], (DEPTH, 2, C_HEADS), dtype=f32,
                                    minval=math.log(1e-3), maxval=math.log(1e-1)))
    return {
        'x': nrm(ks[0], (BATCH, SEQ, D_MODEL)),
        'c': nrm(ks[1], (BATCH, D_MODEL)),
        'ctx': nrm(ks[2], (BATCH, CTX_LEN, D_MODEL)),
        'c_ctx': nrm(ks[3], (D_MODEL,)),
        'w_ada': nrm(ks[4], (DEPTH, D_MODEL, 3 * D_MODEL)) * (0.5 * D_MODEL ** -0.5),
        'b_ada': nrm(ks[5], (DEPTH, 3 * D_MODEL)) * 0.02,
        'norm_w': 1.0 + 0.02 * nrm(ks[6], (DEPTH, D_MODEL)),
        'w_in': nrm(ks[7], (DEPTH, D_MODEL, D_IN)) * D_MODEL ** -0.5,
        'w_out': nrm(ks[8], (DEPTH, D_MIX, D_MODEL)) * D_MIX ** -0.5,
        'a_ln_w': 1.0 + 0.02 * nrm(ks[9], (DEPTH, A_WIDTH)),
        'a_ws': nrm(ks[10], (DEPTH, A_GROUPS, A_CHUNK, A_CHUNK)) * A_CHUNK ** -0.5,
        'a_bs': 1.0 + 0.02 * nrm(ks[11], (DEPTH, A_GROUPS, A_CHUNK)),
        'b_lam': nrm(ks[12], (DEPTH, 4, B_HEAD_DIM)) * 0.1,
        'b_subln_w': 1.0 + 0.02 * nrm(ks[13], (DEPTH, 2 * B_HEAD_DIM)),
        'c_conv_w': nrm(ks[14], (DEPTH, C_CONV, 3 * C_WIDTH)) * C_CONV ** -0.5,
        'c_a_log': jnp.log(jax.random.uniform(ks[15], (DEPTH, 2, C_HEADS), dtype=f32, minval=1.0, maxval=16.0)),
        'c_dt_bias': dt + jnp.log(-jnp.expm1(-dt)),
        'c_norm_w': 1.0 + 0.02 * nrm(ks[16], (DEPTH, C_HEAD_DIM)),
        'final_norm_w': 1.0 + 0.02 * nrm(ks[18], (D_MODEL,)),
    }


def reference(x, c, ctx, c_ctx, w_ada, b_ada, norm_w, w_in, w_out, a_ln_w, a_ws, a_bs,
              b_lam, b_subln_w, c_conv_w, c_a_log, c_dt_bias, c_norm_w, final_norm_w):
    n = x.shape[1]
    rows_count = n // GRID_W
    rows = jnp.repeat(jnp.arange(rows_count), GRID_W)
    cols = jnp.tile(jnp.arange(GRID_W), rows_count)
    c_act = jax.nn.silu(c)
    cc_act = jax.nn.silu(c_ctx)
    xc = ctx
    for i in range(DEPTH):
        x, xc = hybrid_layer(x, xc, c_act, cc_act, w_ada[i], b_ada[i], norm_w[i], w_in[i], w_out[i],
                             a_ln_w[i], a_ws[i], a_bs[i], b_lam[i], b_subln_w[i],
                             c_conv_w[i], c_a_log[i], c_dt_bias[i], c_norm_w[i],
                             rows, cols, i, i < DEPTH - 1)
    return rms_norm(x, final_norm_w)
```

```cpp
#include <hip/hip_runtime.h>
#include <hip/hip_cooperative_groups.h>
#include <cstdio>
namespace cg = cooperative_groups;

#ifndef SINGLE_LAUNCH
#define SINGLE_LAUNCH 1
#endif
#ifndef EN_A
#define EN_A 1
#endif
#ifndef EN_B
#define EN_B 1
#endif
#ifndef EN_C
#define EN_C 1
#endif

#define LAS __attribute__((address_space(3)))
typedef unsigned short bf16_t;
typedef short bf16x8 __attribute__((ext_vector_type(8)));
typedef float f32x4 __attribute__((ext_vector_type(4)));
typedef float f32x2 __attribute__((ext_vector_type(2)));
typedef float f32x16 __attribute__((ext_vector_type(16)));
typedef unsigned u32x4 __attribute__((ext_vector_type(4)));
typedef unsigned u32x2 __attribute__((ext_vector_type(2)));

constexpr int DM = 1024, NBATCH = 32, SEQL = 2048, CTXL = 256;
constexpr int NLAT = NBATCH * SEQL, NCTX = NBATCH * CTXL, NT = NLAT + NCTX;
constexpr int DIN = 3856, NPJ = 3840, LDP = 3328;
constexpr int PA_U = 0, PA_V = 256, PA_Z = 512, PB_Q = 768, PB_K = 1280, PB_Z = 1792, PC_Q = 2304, PC_K = 2560, PC_V = 2816, PC_Z = 3072;
constexpr int LDS_BYTES = 147456;
constexpr int NTHREADS = 512;

constexpr size_t al256(size_t x) { return (x + 255) & ~(size_t)255; }
constexpr size_t WS_MOD = 0;
constexpr size_t WS_SW = WS_MOD + 2ull * 33 * 3072 * 4;
constexpr size_t WS_ROPE = al256(WS_SW + 2ull * 33 * 3856 * 4);
constexpr size_t WS_WX = WS_ROPE + 8192;
constexpr size_t WS_AWS = WS_WX + 65536;
constexpr size_t WS_RROW = WS_AWS + 262144;
constexpr size_t WS_EG = WS_RROW + (size_t)NT * 4;
constexpr size_t WS_PX = WS_EG + 36864;
constexpr size_t WS_WIN = WS_PX + (size_t)NT * 64;
constexpr size_t WS_WOUT = WS_WIN + 2ull * 3840 * 1024 * 2;
constexpr size_t WS_XC1 = WS_WOUT + 2ull * 1024 * 1024 * 2;
constexpr size_t WS_VT = WS_XC1 + (size_t)NCTX * 1024 * 4;
constexpr size_t WS_P = WS_VT + 32ull * 4 * 128 * 2304 * 2;
constexpr size_t WS_H = WS_P + (size_t)NT * LDP * 2;
constexpr size_t GREC = 40960;
constexpr size_t WS_END = WS_H + 9216ull * GREC;
static_assert(WS_END <= (1ull << 30), "workspace");
static_assert((WS_SW % 256) == 0 && (WS_WIN % 256) == 0 && (WS_P % 256) == 0 && (WS_H % 256) == 0 && (WS_VT % 256) == 0 && (WS_PX % 256) == 0, "align");

struct KArgs {
    const float *x, *c, *ctx, *c_ctx, *w_ada, *b_ada, *norm_w, *w_in, *w_out, *a_ln_w, *a_ws, *a_bs, *b_lam, *b_subln_w, *c_conv_w, *c_a_log, *c_dt_bias, *c_norm_w, *final_norm_w;
    float* out; unsigned char* ws; int ph_lo, ph_hi;
};

typedef __bf16 bf16v2 __attribute__((ext_vector_type(2)));
__device__ __forceinline__ unsigned pk2(float lo, float hi) { const f32x2 v = {lo, hi}; const bf16v2 b = __builtin_convertvector(v, bf16v2); return __builtin_bit_cast(unsigned, b); }
__device__ __forceinline__ float bflo(unsigned u) { return __uint_as_float(u << 16); }
__device__ __forceinline__ float bfhi(unsigned u) { return __uint_as_float(u & 0xffff0000u); }
__device__ __forceinline__ bf16_t f2bf(float f) { return (bf16_t)(pk2(f, 0.f) & 0xffffu); }
__device__ __forceinline__ bf16x8 pack8(f32x4 a, f32x4 b) { u32x4 r; r.x = pk2(a[0], a[1]); r.y = pk2(a[2], a[3]); r.z = pk2(b[0], b[1]); r.w = pk2(b[2], b[3]); return __builtin_bit_cast(bf16x8, r); }
__device__ __forceinline__ float silu_f(float v) { return v / (1.f + __expf(-v)); }
__device__ __forceinline__ int pi64(int x) { return (x & 32) | ((x & 12) << 1) | ((x & 16) >> 2) | (x & 3); }
__device__ __forceinline__ int lane_id_v() { int l; asm volatile("v_mbcnt_lo_u32_b32 %0, -1, 0\n\tv_mbcnt_hi_u32_b32 %0, -1, %0" : "=v"(l)); return l; }
__device__ __forceinline__ float shfl_x32(float v, int lane) { return __int_as_float(__builtin_amdgcn_ds_bpermute((lane ^ 32) << 2, __float_as_int(v))); }
#define MFMA16(a, b, c) __builtin_amdgcn_mfma_f32_16x16x32_bf16((a), (b), (c), 0, 0, 0)
#define MFMA32(a, b, c) __builtin_amdgcn_mfma_f32_32x32x16_bf16((a), (b), (c), 0, 0, 0)

namespace pg8 {
constexpr int BM = 256, BK = 64, HALF = 128, HTB = HALF * BK * 2, STAGE_BYTES = 8 * HTB, NXCD = 8, WGM = 8;
__host__ __device__ __forceinline__ int lds_byte(int r, int c) { const int st = (r >> 4) * 2 + (c >> 5), rr = r & 15, cc = c & 31, ob = rr * 64 + cc * 2; return st * 1024 + (ob ^ (((ob >> 9) & 1) << 5)); }
__host__ __device__ __forceinline__ void stage_rc(int b, int& R, int& C) { const int st = b / 1024, sb = b % 1024, swz = sb ^ (((sb >> 9) & 1) << 5); R = (st >> 1) * 16 + swz / 64; C = (st & 1) * 32 + (swz % 64) / 2; }
__host__ __device__ __forceinline__ int perm32(int rho) { const int n = rho >> 4, i = rho & 15; return 8 * (i >> 2) + 4 * n + (i & 3); }
struct Unit { int pm, pn; };
struct Gemm { const bf16_t* A; const bf16_t* Bt; int M, N, K, lda, seg; };
struct StaticOrder {
    int nM, nN, nwg, G, c;
    __device__ void init(int M, int N, int G_, int c_) { nM = M / BM; nN = N / BM; nwg = nM * nN; G = G_; c = c_; }
    __device__ bool next(int i, Unit& u) const {
        const long L = (long)i * G + c; if (L >= nwg) return false;
        int wgid = (int)L; { const int q = nwg / NXCD, r = nwg % NXCD, xcd = wgid % NXCD, off = wgid / NXCD; wgid = (xcd < r ? xcd * (q + 1) : r * (q + 1) + (xcd - r) * q) + off; }
        const int nig = WGM * nN, gid = wgid / nig, fm = gid * WGM, gsz = (nM - fm) < WGM ? (nM - fm) : WGM;
        u.pm = fm + ((wgid % nig) % gsz); u.pn = (wgid % nig) / gsz; return true;
    }
};
__device__ __forceinline__ size_t akb(int seg, int t) { return seg ? (size_t)(t < 4 ? t * 64 : (t < 12 ? PB_Z + (t - 4) * 64 : PC_Z + (t - 12) * 64)) * 2 : (size_t)t * 128; }

template <class Epi>
__device__ __forceinline__ void gemm_phase(LAS unsigned char* lds, const Gemm g, const StaticOrder& S, const Epi& E, int wid) {
    const int lane = lane_id_v(), tid = wid * 64 + lane, wr = wid >> 2, wc = wid & 3, fr = lane & 15, fq = lane >> 4;
    const int K = g.K, nt = K / BK, lda = g.lda, seg = g.seg;
    unsigned voffA[2], voffB[2];
#pragma unroll
    for (int i = 0; i < 2; ++i) { int R, C; stage_rc(tid * 16 + i * 8192, R, C); const int Rb = Epi::PERM ? ((R & ~31) + perm32(R & 31)) : R;
        voffA[i] = (unsigned)(R * lda + C) * 2u; voffB[i] = (unsigned)(Rb * K + C) * 2u; }
    const size_t kstep = (size_t)(BK * 2);
    const size_t hstepA = (size_t)HALF * lda * 2, hstepB = (size_t)HALF * K * 2;
    const size_t tstepA = 2 * hstepA, tstepB = 2 * hstepB;
    const unsigned ldsw = (unsigned)wid * 1024u;
    const int aoff = lds_byte(wr * 64 + fr, fq * 8), boff = lds_byte(wc * 32 + fr, fq * 8);
#define PG8_SA(b, h) (((b) * 2 + (h)) * HTB)
#define PG8_SB(b, h) ((4 + (b) * 2 + (h)) * HTB)
#define PG8_STAGE(bufoff, gbase, voff) do { _Pragma("unroll") for (int _i = 0; _i < 2; ++_i) \
        __builtin_amdgcn_global_load_lds((const unsigned*)((const char*)(gbase) + (voff)[_i]), (LAS unsigned*)(lds + (bufoff) + ldsw + _i * 8192), 16, 0, 0); } while (0)
#define PG8_LDA(dst, b, h) do { _Pragma("unroll") for (int m = 0; m < 4; ++m) _Pragma("unroll") for (int k = 0; k < 2; ++k) dst[m][k] = *(const LAS bf16x8*)(lds + PG8_SA(b, h) + aoff + m * 2048 + k * 1024); } while (0)
#define PG8_LDB(dst, b, h) do { _Pragma("unroll") for (int n = 0; n < 2; ++n) _Pragma("unroll") for (int k = 0; k < 2; ++k) dst[n][k] = *(const LAS bf16x8*)(lds + PG8_SB(b, h) + boff + n * 2048 + k * 1024); } while (0)
#define PG8_MMA(ai, bj, At, Bt) do { __builtin_amdgcn_s_setprio(1); _Pragma("unroll") for (int m = 0; m < 4; ++m) _Pragma("unroll") for (int n = 0; n < 2; ++n) _Pragma("unroll") for (int k = 0; k < 2; ++k) \
        acc[ai][bj][m][n] = __builtin_amdgcn_mfma_f32_16x16x32_bf16(Bt[n][k], At[m][k], acc[ai][bj][m][n], 0, 0, 0); __builtin_amdgcn_s_setprio(0); } while (0)
#define PG8_WAIT_V(n) asm volatile("s_waitcnt vmcnt(" #n ")" ::: "memory")
#define PG8_WAIT_L(n) asm volatile("s_waitcnt lgkmcnt(" #n ")" ::: "memory")
#define PG8_BAR __builtin_amdgcn_s_barrier()
#define PG8_SCHED __builtin_amdgcn_sched_barrier(0)
    Unit cur, nxt; int ui = 0;
    if (!S.next(0, cur)) return;
    f32x4 acc[2][2][4][2];
#pragma unroll
    for (int a = 0; a < 2; ++a)
#pragma unroll
        for (int b = 0; b < 2; ++b)
#pragma unroll
            for (int m = 0; m < 4; ++m)
#pragma unroll
                for (int n = 0; n < 2; ++n) acc[a][b][m][n] = (f32x4){0.f, 0.f, 0.f, 0.f};
    bf16x8 At[4][2], B0[2][2], B1[2][2];
    const char* cA = (const char*)g.A + (size_t)cur.pm * tstepA; const char* cB = (const char*)g.Bt + (size_t)cur.pn * tstepB;
    PG8_STAGE(PG8_SB(0, 0), cB, voffB); PG8_STAGE(PG8_SA(0, 0), cA + akb(seg, 0), voffA); PG8_STAGE(PG8_SB(0, 1), cB + hstepB, voffB); PG8_STAGE(PG8_SA(0, 1), cA + akb(seg, 0) + hstepA, voffA);
    if (wr == 1) PG8_BAR;
    PG8_WAIT_V(4); PG8_BAR;
    PG8_STAGE(PG8_SB(1, 0), cB + kstep, voffB); PG8_STAGE(PG8_SA(1, 0), cA + akb(seg, 1), voffA); PG8_STAGE(PG8_SB(1, 1), cB + hstepB + kstep, voffB);
    PG8_WAIT_V(6); PG8_BAR;
    for (;;) {
        const bool has_next = S.next(ui + 1, nxt);
        const char* nA = has_next ? (const char*)g.A + (size_t)nxt.pm * tstepA : cA; const char* nB = has_next ? (const char*)g.Bt + (size_t)nxt.pn * tstepB : cB;
        for (int t = 0; t < nt; t += 2) {
            const bool last = (t == nt - 2);
            const char* a1 = cA + akb(seg, t + 1);
            const char* a2 = last ? nA + akb(seg, 0) : cA + akb(seg, t + 2); const char* b2 = last ? nB : cB + (size_t)(t + 2) * kstep;
            const char* a3 = last ? nA + akb(seg, 1) : cA + akb(seg, t + 3); const char* b3 = b2 + kstep;
            PG8_LDB(B0, 0, 0); PG8_SCHED; PG8_LDA(At, 0, 0); PG8_STAGE(PG8_SA(1, 1), a1 + hstepA, voffA);
            PG8_WAIT_L(8); PG8_BAR; PG8_WAIT_L(0); PG8_MMA(0, 0, At, B0); PG8_BAR; PG8_SCHED;
            PG8_LDB(B1, 0, 1); PG8_STAGE(PG8_SB(0, 0), b2, voffB);
            PG8_BAR; PG8_WAIT_L(0); PG8_MMA(0, 1, At, B1); PG8_BAR;
            PG8_LDA(At, 0, 1); PG8_STAGE(PG8_SA(0, 0), a2, voffA);
            PG8_BAR; PG8_WAIT_L(0); PG8_MMA(1, 0, At, B0); PG8_BAR; PG8_SCHED;
            PG8_STAGE(PG8_SB(0, 1), b2 + hstepB, voffB);
            PG8_WAIT_V(6); PG8_BAR; PG8_MMA(1, 1, At, B1); PG8_BAR;
            PG8_LDB(B0, 1, 0); PG8_SCHED; PG8_LDA(At, 1, 0); PG8_STAGE(PG8_SA(0, 1), a2 + hstepA, voffA);
            PG8_WAIT_L(8); PG8_BAR; PG8_WAIT_L(0); PG8_MMA(0, 0, At, B0); PG8_BAR; PG8_SCHED;
            PG8_LDB(B1, 1, 1); PG8_STAGE(PG8_SB(1, 0), b3, voffB);
            PG8_BAR; PG8_WAIT_L(0); PG8_MMA(0, 1, At, B1); PG8_BAR;
            PG8_LDA(At, 1, 1); PG8_STAGE(PG8_SA(1, 0), a3, voffA);
            PG8_BAR; PG8_WAIT_L(0); PG8_MMA(1, 0, At, B0); PG8_BAR; PG8_SCHED;
            PG8_STAGE(PG8_SB(1, 1), b3 + hstepB, voffB);
            PG8_WAIT_V(6); PG8_BAR; PG8_MMA(1, 1, At, B1); PG8_BAR;
        }
        E(acc, cur, wr, wc, fr, fq, lane);
        if (!has_next) break;
#pragma unroll
        for (int a = 0; a < 2; ++a)
#pragma unroll
            for (int b = 0; b < 2; ++b)
#pragma unroll
                for (int m = 0; m < 4; ++m)
#pragma unroll
                    for (int n = 0; n < 2; ++n) acc[a][b][m][n] = (f32x4){0.f, 0.f, 0.f, 0.f};
        cur = nxt; cA = nA; cB = nB; ++ui;
    }
    PG8_WAIT_V(0);
    if (wr == 0) PG8_BAR;
    PG8_BAR;
#undef PG8_SA
#undef PG8_SB
#undef PG8_STAGE
#undef PG8_LDA
#undef PG8_LDB
#undef PG8_MMA
#undef PG8_WAIT_V
#undef PG8_WAIT_L
#undef PG8_BAR
#undef PG8_SCHED
}
}

struct EpiP {
    static constexpr bool PERM = true;
    bf16_t* P; bf16_t* VT; const float* rrow; const float* sW; const f32x2* rope;
    __device__ __forceinline__ void operator()(const f32x4 (&acc)[2][2][4][2], const pg8::Unit& u, int wr, int wc, int fr, int fq, int lane) const {
        const int row0 = u.pm * 256 + wr * 64 + fr;
        const bool lat = u.pm < 256;
        const int mrow = lat ? (u.pm >> 3) : 32;
        const int pn = u.pn;
        const int ocol0 = pn * 256 + wc * 32 + 8 * fq;
        const int pcol0 = (pn < 7 ? pn * 256 : (pn - 2) * 256) + wc * 32 + 8 * fq;
        const bool do_rope = lat && pn >= 3 && pn <= 6;
        const bool is_v = (pn == 7 || pn == 8);
        f32x4 bv[2][2];
#pragma unroll
        for (int bj = 0; bj < 2; ++bj)
#pragma unroll
            for (int n = 0; n < 2; ++n) bv[bj][n] = *(const f32x4*)(sW + (size_t)mrow * DIN + ocol0 + bj * 128 + 4 * n);
#pragma unroll
        for (int ai = 0; ai < 2; ++ai)
#pragma unroll
            for (int m = 0; m < 4; ++m) {
                const int row = row0 + ai * 128 + m * 16;
                const float rr = rrow[row];
#pragma unroll
                for (int bj = 0; bj < 2; ++bj) {
                    f32x4 v0 = acc[ai][bj][m][0] * rr + bv[bj][0], v1 = acc[ai][bj][m][1] * rr + bv[bj][1];
                    if (do_rope) {
                        const int t = row & 2047;
                        const int pos = (wc & 1) ? (t & 63) : (t >> 6);
                        const f32x4* tp = (const f32x4*)(rope + pos * 16 + 8 * (fq & 1));
                        const f32x4 t0 = tp[0], t1 = tp[1], t2 = tp[2], t3 = tp[3];
                        const float sg = (fq >= 2) ? 1.f : -1.f;
                        f32x4 p0, p1;
#pragma unroll
                        for (int e = 0; e < 4; ++e) { p0[e] = shfl_x32(v0[e], lane); p1[e] = shfl_x32(v1[e], lane); }
                        v0[0] = v0[0] * t0[0] + sg * p0[0] * t0[1]; v0[1] = v0[1] * t0[2] + sg * p0[1] * t0[3];
                        v0[2] = v0[2] * t1[0] + sg * p0[2] * t1[1]; v0[3] = v0[3] * t1[2] + sg * p0[3] * t1[3];
                        v1[0] = v1[0] * t2[0] + sg * p1[0] * t2[1]; v1[1] = v1[1] * t2[2] + sg * p1[1] * t2[3];
                        v1[2] = v1[2] * t3[0] + sg * p1[2] * t3[1]; v1[3] = v1[3] * t3[2] + sg * p1[3] * t3[3];
                    }
                    if (is_v) {
                        const int hh = 2 * (pn - 7) + bj;
                        int bb, key;
                        if (lat) { bb = row >> 11; key = 256 + (row & 2047); } else { const int rc = row - NLAT; bb = rc >> 8; key = rc & 255; }
                        const int kx = key & 15;
                        const int kp = (key & ~15) | (kx & 3) | ((kx & 4) << 1) | ((kx & 8) >> 1);
                        bf16_t* vp = VT + ((size_t)(bb * 4 + hh) * 128 + wc * 32 + 8 * fq) * 2304 + kp;
#pragma unroll
                        for (int e = 0; e < 4; ++e) { vp[(size_t)e * 2304] = f2bf(v0[e]); vp[(size_t)(4 + e) * 2304] = f2bf(v1[e]); }
                    } else {
                        u32x4 w; w.x = pk2(v0[0], v0[1]); w.y = pk2(v0[2], v0[3]); w.z = pk2(v1[0], v1[1]); w.w = pk2(v1[2], v1[3]);
                        *(u32x4*)(P + (size_t)row * LDP + pcol0 + bj * 128) = w;
                    }
                }
                asm volatile("" ::: "memory");
            }
    }
};
struct EpiRes {
    static constexpr bool PERM = false;
    const float* xlat; const float* xctx; float* olat; float* octx; const float* gate;
    __device__ __forceinline__ void operator()(const f32x4 (&acc)[2][2][4][2], const pg8::Unit& u, int wr, int wc, int fr, int fq, int lane) const {
        const int row0 = u.pm * 256 + wr * 64 + fr, col0 = u.pn * 256 + wc * 32 + 4 * fq;
        const bool lat = u.pm < 256; const int mrow = lat ? (u.pm >> 3) : 32;
        f32x4 gv[2][2];
#pragma unroll
        for (int bj = 0; bj < 2; ++bj)
#pragma unroll
            for (int n = 0; n < 2; ++n) gv[bj][n] = *(const f32x4*)(gate + (size_t)mrow * 3072 + col0 + bj * 128 + n * 16);
#pragma unroll
        for (int ai = 0; ai < 2; ++ai)
#pragma unroll
            for (int m = 0; m < 4; ++m) {
                const int row = row0 + ai * 128 + m * 16;
                const float* src = lat ? xlat + (size_t)row * DM : xctx + (size_t)(row - NLAT) * DM;
                float* dst = lat ? olat + (size_t)row * DM : octx + (size_t)(row - NLAT) * DM;
#pragma unroll
                for (int bj = 0; bj < 2; ++bj)
#pragma unroll
                    for (int n = 0; n < 2; ++n) { const f32x4 xs = *(const f32x4*)(src + col0 + bj * 128 + n * 16); *(f32x4*)(dst + col0 + bj * 128 + n * 16) = xs + gv[bj][n] * acc[ai][bj][m][n]; }
                asm volatile("" ::: "memory");
            }
    }
};

__device__ __attribute__((noinline)) void small33(LAS unsigned char* lds, const float* vecs, int vstride, const float* vec32, bool act,
                                        const float* W, int ldw, int ncols, int n0, const float* bias, float* out, int ldo, int tid) {
    LAS float* cs = (LAS float*)lds;
    LAS float* red = (LAS float*)(lds + 36864);
    const int col = tid & 63, ks = tid >> 6;
    float acc[33];
#pragma unroll
    for (int r = 0; r < 33; ++r) acc[r] = 0.f;
    const bool cok = (n0 + col) < ncols;
    for (int kc = 0; kc < 4; ++kc) {
        for (int idx = tid; idx < 33 * 256; idx += NTHREADS) {
            const int r = idx >> 8, kk = idx & 255;
            float v = (r < 32) ? vecs[(size_t)r * vstride + kc * 256 + kk] : vec32[kc * 256 + kk];
            if (act) v = v / (1.f + expf(-v));
            cs[kk * 36 + r] = v;
        }
        __syncthreads();
        for (int i = 0; i < 32; ++i) {
            const int kk = ks * 32 + i;
            const float w = cok ? W[(size_t)(kc * 256 + kk) * ldw + n0 + col] : 0.f;
#pragma unroll
            for (int r4 = 0; r4 < 8; ++r4) { const f32x4 c4 = *(const LAS f32x4*)(cs + kk * 36 + r4 * 4);
                acc[r4 * 4 + 0] += c4[0] * w; acc[r4 * 4 + 1] += c4[1] * w; acc[r4 * 4 + 2] += c4[2] * w; acc[r4 * 4 + 3] += c4[3] * w; }
            acc[32] += cs[kk * 36 + 32] * w;
        }
        __syncthreads();
    }
#pragma unroll
    for (int r = 0; r < 33; ++r) red[(ks * 33 + r) * 64 + col] = acc[r];
    __syncthreads();
    for (int idx = tid; idx < 33 * 64; idx += NTHREADS) {
        const int r = idx >> 6, c = idx & 63;
        float s = 0.f;
#pragma unroll
        for (int k = 0; k < 8; ++k) s += red[(k * 33 + r) * 64 + c];
        if (n0 + c < ncols) out[(size_t)r * ldo + n0 + c] = s + (bias ? bias[n0 + c] : 0.f);
    }
    __syncthreads();
}

__device__ __attribute__((noinline)) void tconv_tile(LAS unsigned char* lds, const float* src, int lds_, bf16_t* dst, int ldd, int k0, int n0, int tid) {
    LAS float* sm = (LAS float*)lds;
    { const int r = tid >> 4, c4 = (tid & 15) * 4;
#pragma unroll
      for (int ps = 0; ps < 2; ++ps) { const int row = r + 32 * ps; const f32x4 v = *(const f32x4*)(src + (size_t)(k0 + row) * lds_ + n0 + c4);
          sm[row * 65 + c4 + 0] = v[0]; sm[row * 65 + c4 + 1] = v[1]; sm[row * 65 + c4 + 2] = v[2]; sm[row * 65 + c4 + 3] = v[3]; } }
    __syncthreads();
    { const int n = tid >> 3, k8 = (tid & 7) * 8; u32x4 w;
      w.x = pk2(sm[(k8 + 0) * 65 + n], sm[(k8 + 1) * 65 + n]); w.y = pk2(sm[(k8 + 2) * 65 + n], sm[(k8 + 3) * 65 + n]);
      w.z = pk2(sm[(k8 + 4) * 65 + n], sm[(k8 + 5) * 65 + n]); w.w = pk2(sm[(k8 + 6) * 65 + n], sm[(k8 + 7) * 65 + n]);
      *(u32x4*)(dst + (size_t)(n0 + n) * ldd + k0 + k8) = w; }
    __syncthreads();
}

__device__ __attribute__((noinline)) void panel_tile(LAS unsigned char* lds, unsigned char* ws, const float* norm_w_l, int l, int tile, const float* xlat, const float* xctx, int tid) {
    LAS float* gvec = (LAS float*)lds;
    LAS unsigned char* wxl = lds + 4096;
    const int lane = tid & 63, w = tid >> 6, fr = lane & 15, fq = lane >> 4;
    const int rowb = tile * 128;
    const bool lat = rowb < NLAT;
    const int mrow = lat ? (rowb >> 11) : 32;
    const float* modl = (const float*)(ws + WS_MOD) + (size_t)l * 33 * 3072;
    for (int k = tid; k < 1024; k += NTHREADS) gvec[k] = norm_w_l[k] * (1.f + modl[(size_t)mrow * 3072 + 1024 + k]);
    { const unsigned char* wx = ws + WS_WX + (size_t)l * 32768;
#pragma unroll
      for (int i = 0; i < 4; ++i) { const int idx = tid + 512 * i, r = idx >> 7, cc = idx & 127; *(LAS u32x4*)(wxl + r * 2064 + cc * 16) = *(const u32x4*)(wx + (size_t)idx * 16); } }
    __syncthreads();
    const int row = rowb + w * 16 + fr;
    const float* xr = lat ? xlat + (size_t)row * DM : xctx + (size_t)(row - NLAT) * DM;
    bf16_t* hr = (bf16_t*)(ws + WS_H) + (size_t)row * DM;
    f32x4 acc = {0.f, 0.f, 0.f, 0.f}; float ss = 0.f;
    for (int kk = 0; kk < 16; ++kk) {
        const int k0 = kk * 64 + fq * 16;
        f32x4 xv[4], gv[4];
#pragma unroll
        for (int j = 0; j < 4; ++j) { xv[j] = *(const f32x4*)(xr + k0 + 4 * j); gv[j] = *(const LAS f32x4*)(gvec + k0 + 4 * j); }
#pragma unroll
        for (int j = 0; j < 4; ++j) { ss += xv[j][0] * xv[j][0] + xv[j][1] * xv[j][1] + xv[j][2] * xv[j][2] + xv[j][3] * xv[j][3]; xv[j] = xv[j] * gv[j]; }
        const bf16x8 alo = pack8(xv[0], xv[1]), ahi = pack8(xv[2], xv[3]);
        *(bf16x8*)(hr + k0) = alo; *(bf16x8*)(hr + k0 + 8) = ahi;
        const bf16x8 blo = *(const LAS bf16x8*)(wxl + fr * 2064 + k0 * 2), bhi = *(const LAS bf16x8*)(wxl + fr * 2064 + k0 * 2 + 16);
        acc = MFMA16(alo, blo, acc); acc = MFMA16(ahi, bhi, acc);
    }
    ss += __shfl_xor(ss, 16); ss += __shfl_xor(ss, 32);
    if (fq == 0) ((float*)(ws + WS_RROW))[row] = rsqrtf(ss * (1.f / 1024.f) + 1e-6f);
    float* px = (float*)(ws + WS_PX);
#pragma unroll
    for (int r = 0; r < 4; ++r) px[(size_t)(rowb + w * 16 + fq * 4 + r) * 16 + fr] = acc[r];
    __syncthreads();
}

__device__ __attribute__((noinline)) void gmlp_tile(LAS unsigned char* lds, unsigned char* ws, const float* ln_w_l, const float* a_bs_l, int l, int R0, int tid) {
    bf16_t* P = (bf16_t*)(ws + WS_P);
    LAS bf16_t* vcT = (LAS bf16_t*)lds;
    const int lane = tid & 63, w = tid >> 6, fr = lane & 15, fq = lane >> 4;
    {
        const int t = tid >> 2, gq = tid & 3;
        const bf16_t* vp = P + (size_t)(R0 + t) * LDP + PA_V + gq * 64;
        float xv[64];
#pragma unroll
        for (int i = 0; i < 8; ++i) { const u32x4 q = *(const u32x4*)(vp + i * 8);
            xv[i * 8 + 0] = bflo(q.x); xv[i * 8 + 1] = bfhi(q.x); xv[i * 8 + 2] = bflo(q.y); xv[i * 8 + 3] = bfhi(q.y);
            xv[i * 8 + 4] = bflo(q.z); xv[i * 8 + 5] = bfhi(q.z); xv[i * 8 + 6] = bflo(q.w); xv[i * 8 + 7] = bfhi(q.w); }
        float s = 0.f;
#pragma unroll
        for (int i = 0; i < 64; ++i) s += xv[i];
        s += __shfl_xor(s, 1); s += __shfl_xor(s, 2);
        const float mean = s * (1.f / 256.f);
        float q2 = 0.f;
#pragma unroll
        for (int i = 0; i < 64; ++i) { const float d = xv[i] - mean; q2 += d * d; }
        q2 += __shfl_xor(q2, 1); q2 += __shfl_xor(q2, 2);
        const float rs = rsqrtf(q2 * (1.f / 256.f) + 1e-5f);
        const float* lw = ln_w_l + gq * 64;
#pragma unroll
        for (int i = 0; i < 64; ++i) vcT[(gq * 64 + i) * 136 + t] = f2bf((xv[i] - mean) * rs * lw[i]);
    }
    __syncthreads();
    const int g = w >> 1, ih = w & 1;
    f32x4 acc[4][4];
#pragma unroll
    for (int mi = 0; mi < 4; ++mi)
#pragma unroll
        for (int ni = 0; ni < 4; ++ni) acc[mi][ni] = (f32x4){0.f, 0.f, 0.f, 0.f};
    const bf16_t* aw = (const bf16_t*)(ws + WS_AWS) + (size_t)(l * 4 + g) * 128 * 128;
#pragma unroll
    for (int ks = 0; ks < 4; ++ks) {
        bf16x8 af[4], bf[4];
#pragma unroll
        for (int mi = 0; mi < 4; ++mi) af[mi] = *(const bf16x8*)(aw + (size_t)(ih * 64 + mi * 16 + fr) * 128 + ks * 32 + fq * 8);
#pragma unroll
        for (int ni = 0; ni < 4; ++ni) bf[ni] = *(const LAS bf16x8*)(vcT + (g * 64 + ni * 16 + fr) * 136 + ks * 32 + fq * 8);
#pragma unroll
        for (int mi = 0; mi < 4; ++mi)
#pragma unroll
            for (int ni = 0; ni < 4; ++ni) acc[mi][ni] = MFMA16(bf[ni], af[mi], acc[mi][ni]);
    }
#pragma unroll
    for (int mi = 0; mi < 4; ++mi) {
        const int tok = ih * 64 + mi * 16 + fr;
        const float bs = a_bs_l[g * 128 + tok];
        bf16_t* pr = P + (size_t)(R0 + tok) * LDP;
#pragma unroll
        for (int ni = 0; ni < 4; ++ni) {
            const int c0 = g * 64 + ni * 16 + fq * 4;
            const u32x2 uu = *(const u32x2*)(pr + PA_U + c0), zz = *(const u32x2*)(pr + PA_Z + c0);
            const float y0 = bflo(uu.x) * (acc[mi][ni][0] + bs) * silu_f(bflo(zz.x));
            const float y1 = bfhi(uu.x) * (acc[mi][ni][1] + bs) * silu_f(bfhi(zz.x));
            const float y2 = bflo(uu.y) * (acc[mi][ni][2] + bs) * silu_f(bflo(zz.y));
            const float y3 = bfhi(uu.y) * (acc[mi][ni][3] + bs) * silu_f(bfhi(zz.y));
            u32x2 o; o.x = pk2(y0, y1); o.y = pk2(y2, y3);
            *(u32x2*)(pr + PA_U + c0) = o;
        }
    }
    __syncthreads();
}

__device__ __forceinline__ void attn_tile(LAS unsigned char* lds, unsigned char* ws, const float* sw, int b, int h, int qrow0, int nkt, float lam, float osc, int w) {
    bf16_t* P = (bf16_t*)(ws + WS_P);
    const bf16_t* VT = (const bf16_t*)(ws + WS_VT);
    const int lane = lane_id_v(), tid = w * 64 + lane, sub = w >> 2, qw = w & 3, l31 = lane & 31, hi = lane >> 5;
    const int qrow = qrow0 + qw * 32 + l31;
    bf16x8 qf[4];
    { const bf16_t* qp = P + (size_t)qrow * LDP + PB_Q + (2 * h + sub) * 64 + hi * 8;
#pragma unroll
      for (int ks = 0; ks < 4; ++ks) qf[ks] = *(const bf16x8*)(qp + ks * 16); }
    f32x16 O[4];
#pragma unroll
    for (int d = 0; d < 4; ++d)
#pragma unroll
        for (int r = 0; r < 16; ++r) O[d][r] = 0.f;
    float m = -INFINITY, lsum = 0.f;
    const float cs = 0.125f * 1.44269504088896f;
    u32x4 kr[2], vr[2];
    const bf16_t* vbase = VT + (size_t)(b * 4 + h) * 128 * 2304;
#define ATT_LOAD(kt) do { const int krow0_ = ((kt) < 4) ? (NLAT + b * 256 + (kt) * 64) : (b * 2048 + ((kt) - 4) * 64); \
        _Pragma("unroll") for (int i_ = 0; i_ < 2; ++i_) { const int idx_ = tid + 512 * i_; \
            kr[i_] = *(const u32x4*)(P + (size_t)(krow0_ + (idx_ >> 4)) * LDP + PB_K + 2 * h * 64 + (idx_ & 15) * 8); \
            vr[i_] = *(const u32x4*)(vbase + (size_t)(idx_ >> 3) * 2304 + (kt) * 64 + (idx_ & 7) * 8); } } while (0)
#define ATT_STORE(s) do { _Pragma("unroll") for (int i_ = 0; i_ < 2; ++i_) { const int idx_ = tid + 512 * i_; const int key_ = idx_ >> 4, part_ = idx_ & 15; \
            *(LAS u32x4*)(lds + (s) * 36864 + (((part_ >> 3) * 64 + key_) * 72 + (part_ & 7) * 8) * 2) = kr[i_]; \
            *(LAS u32x4*)(lds + (s) * 36864 + 18432 + ((idx_ >> 3) * 72 + (idx_ & 7) * 8) * 2) = vr[i_]; } } while (0)
    ATT_LOAD(0); ATT_STORE(0); __syncthreads();
    for (int kt = 0; kt < nkt; ++kt) {
        const int s = kt & 1;
        if (kt + 1 < nkt) ATT_LOAD(kt + 1);
        f32x16 S0, S1;
#pragma unroll
        for (int r = 0; r < 16; ++r) { S0[r] = 0.f; S1[r] = 0.f; }
        const LAS unsigned char* kb_ = lds + s * 36864 + sub * (64 * 72 * 2);
#pragma unroll
        for (int ks = 0; ks < 4; ++ks) {
            const bf16x8 a0 = *(const LAS bf16x8*)(kb_ + (l31 * 72 + ks * 16 + hi * 8) * 2);
            const bf16x8 a1 = *(const LAS bf16x8*)(kb_ + ((32 + l31) * 72 + ks * 16 + hi * 8) * 2);
            S0 = MFMA32(a0, qf[ks], S0); S1 = MFMA32(a1, qf[ks], S1);
        }
        float mx = S0[0];
#pragma unroll
        for (int r = 1; r < 16; ++r) mx = fmaxf(mx, S0[r]);
#pragma unroll
        for (int r = 0; r < 16; ++r) mx = fmaxf(mx, S1[r]);
        mx = fmaxf(mx, shfl_x32(mx, lane));
        const float mn = fmaxf(m, mx);
        const float alpha = __builtin_amdgcn_exp2f((m - mn) * cs);
        m = mn;
        const float mc = mn * cs;
        float rs = 0.f;
        bf16x8 pk[2][2];
#pragma unroll
        for (int s2 = 0; s2 < 2; ++s2) {
            u32x4 t0, t1;
#pragma unroll
            for (int j = 0; j < 4; ++j) {
                const float e0 = __builtin_amdgcn_exp2f(S0[8 * s2 + 2 * j] * cs - mc), e1 = __builtin_amdgcn_exp2f(S0[8 * s2 + 2 * j + 1] * cs - mc);
                const float f0 = __builtin_amdgcn_exp2f(S1[8 * s2 + 2 * j] * cs - mc), f1 = __builtin_amdgcn_exp2f(S1[8 * s2 + 2 * j + 1] * cs - mc);
                rs += (e0 + e1) + (f0 + f1);
                t0[j] = pk2(e0, e1); t1[j] = pk2(f0, f1);
            }
            pk[0][s2] = __builtin_bit_cast(bf16x8, t0); pk[1][s2] = __builtin_bit_cast(bf16x8, t1);
        }
        lsum = lsum * alpha + rs;
#pragma unroll
        for (int d = 0; d < 4; ++d)
#pragma unroll
            for (int r = 0; r < 16; ++r) O[d][r] *= alpha;
        const LAS unsigned char* vb_ = lds + s * 36864 + 18432;
#pragma unroll
        for (int d = 0; d < 4; ++d)
#pragma unroll
            for (int kb = 0; kb < 2; ++kb)
#pragma unroll
                for (int s2 = 0; s2 < 2; ++s2) {
                    const bf16x8 av = *(const LAS bf16x8*)(vb_ + ((d * 32 + l31) * 72 + kb * 32 + s2 * 16 + hi * 8) * 2);
                    O[d] = MFMA32(av, pk[kb][s2], O[d]);
                }
        if (kt + 1 < nkt) ATT_STORE(s ^ 1);
        __syncthreads();
    }
#undef ATT_LOAD
#undef ATT_STORE
    lsum += shfl_x32(lsum, lane);
    const float inv = 1.f / lsum;
    LAS float* O2 = (LAS float*)lds;
    if (sub == 1) {
#pragma unroll
        for (int d = 0; d < 4; ++d)
#pragma unroll
            for (int rg = 0; rg < 4; ++rg) { f32x4 v = {O[d][4 * rg] * inv, O[d][4 * rg + 1] * inv, O[d][4 * rg + 2] * inv, O[d][4 * rg + 3] * inv};
                *(LAS f32x4*)(O2 + (qw * 32 + l31) * 132 + d * 32 + 8 * rg + 4 * hi) = v; }
    }
    __syncthreads();
    if (sub == 0) {
        float ss = 0.f;
#pragma unroll
        for (int d = 0; d < 4; ++d)
#pragma unroll
            for (int rg = 0; rg < 4; ++rg) { const f32x4 o2 = *(const LAS f32x4*)(O2 + (qw * 32 + l31) * 132 + d * 32 + 8 * rg + 4 * hi);
#pragma unroll
                for (int e = 0; e < 4; ++e) { const float o = O[d][4 * rg + e] * inv - lam * o2[e]; O[d][4 * rg + e] = o; ss += o * o; } }
        ss += shfl_x32(ss, lane);
        const float rr = rsqrtf(ss * (1.f / 128.f) + 1e-6f) * osc;
        bf16_t* zp0 = P + (size_t)qrow * LDP + PB_Z + h * 128;
#pragma unroll
        for (int d = 0; d < 4; ++d)
#pragma unroll
            for (int rg = 0; rg < 4; ++rg) { const int dv0 = d * 32 + 8 * rg + 4 * hi;
                const f32x4 w4 = *(const f32x4*)(sw + dv0); const u32x2 zz = *(const u32x2*)(zp0 + dv0);
                const float y0 = O[d][4 * rg + 0] * rr * w4[0] * silu_f(bflo(zz.x)), y1 = O[d][4 * rg + 1] * rr * w4[1] * silu_f(bfhi(zz.x));
                const float y2 = O[d][4 * rg + 2] * rr * w4[2] * silu_f(bflo(zz.y)), y3 = O[d][4 * rg + 3] * rr * w4[3] * silu_f(bfhi(zz.y));
                u32x2 o; o.x = pk2(y0, y1); o.y = pk2(y2, y3); *(u32x2*)(zp0 + dv0) = o; }
    }
    __syncthreads();
}

template <int DD>
__device__ __forceinline__ void gdn_solve(const LAS float* Lb, const LAS float* src, const LAS float* fac, int lane, int part, unsigned char* rec) {
    float x[64];
#pragma unroll
    for (int p = 0; p < 64; ++p) {
        const int tn = DD ? 63 - p : p;
        const float rhs = src[tn * 68 + lane] * fac[p];
        float s0 = 0.f, s1 = 0.f, s2 = 0.f, s3 = 0.f;
#pragma unroll
        for (int q = 0; q < p; q += 4) {
            f32x4 lv;
            if (DD == 0) lv = *(const LAS f32x4*)(Lb + p * 68 + q);
            else { const f32x4 t = *(const LAS f32x4*)(Lb + (63 - p) * 68 + (60 - q)); lv = (f32x4){t[3], t[2], t[1], t[0]}; }
            s0 += lv[0] * x[q];
            if (q + 1 < p) s1 += lv[1] * x[q + 1];
            if (q + 2 < p) s2 += lv[2] * x[q + 2];
            if (q + 3 < p) s3 += lv[3] * x[q + 3];
        }
        x[p] = rhs - ((s0 + s1) + (s2 + s3));
    }
    if (part == 0) {
        bf16_t* ut = (bf16_t*)(rec + 32768) + lane * 64;
#pragma unroll
        for (int i = 0; i < 8; ++i) { u32x4 w; w.x = pk2(x[8 * i], x[8 * i + 1]); w.y = pk2(x[8 * i + 2], x[8 * i + 3]); w.z = pk2(x[8 * i + 4], x[8 * i + 5]); w.w = pk2(x[8 * i + 6], x[8 * i + 7]); *(u32x4*)(ut + 8 * i) = w; }
    } else {
        bf16_t* wn = (bf16_t*)rec + pi64(lane);
#pragma unroll
        for (int p = 0; p < 64; ++p) wn[p * 64] = f2bf(-x[p]);
    }
}

__device__ __attribute__((noinline)) void gdn_prep_tile(LAS unsigned char* lds, unsigned char* ws, const float* conv_w_l, const float* a_log_l, const float* dt_bias_l, int l, int b, int seg, int c, int hp, int tid) {
    const bf16_t* P = (const bf16_t*)(ws + WS_P);
    const int hh = tid >> 8, ltid = tid & 255, lane = tid & 63, wv = (tid >> 6) & 3, fr = lane & 15, fq = lane >> 4;
    const int h = hp * 2 + hh;
    LAS unsigned char* hb = lds + hh * 71680;
    LAS float* qf = (LAS float*)hb; LAS float* kf = (LAS float*)(hb + 17408); LAS float* vf = (LAS float*)(hb + 34816); LAS float* Lb = (LAS float*)(hb + 52224);
    LAS float* beta = (LAS float*)(hb + 69632); LAS float* gg = (LAS float*)(hb + 70144); LAS float* gc = (LAS float*)(hb + 70656); LAS float* fw = (LAS float*)(hb + 71168);
    const int seglen = seg ? SEQL : CTXL;
    const int rowbase = seg ? b * SEQL : NLAT + b * CTXL;
    const int mrow = seg ? b : 32;
    {
        const int ch2 = ltid & 31, tg = ltid >> 5;
#pragma unroll
        for (int part = 0; part < 3; ++part) {
            const int col = PC_Q + part * 256 + h * 64 + 2 * ch2;
            const float* cw = conv_w_l + part * 256 + h * 64 + 2 * ch2;
            float w0[5], w1[5];
#pragma unroll
            for (int j = 0; j < 5; ++j) { const f32x2 t = *(const f32x2*)(cw + j * 768); w0[j] = t[0]; w1[j] = t[1]; }
            float x0[12], x1[12];
#pragma unroll
            for (int i = 0; i < 12; ++i) { const int tt = c * 64 + tg * 8 - 2 + i;
                unsigned u = 0u; if (tt >= 0 && tt < seglen) u = *(const unsigned*)(P + (size_t)(rowbase + tt) * LDP + col);
                x0[i] = bflo(u); x1[i] = bfhi(u); }
            LAS float* dst = part == 0 ? qf : (part == 1 ? kf : vf);
#pragma unroll
            for (int o = 0; o < 8; ++o) { float s0 = 0.f, s1 = 0.f;
#pragma unroll
                for (int j = 0; j < 5; ++j) { s0 += x0[o + j] * w0[j]; s1 += x1[o + j] * w1[j]; }
                *(LAS f32x2*)(dst + (tg * 8 + o) * 68 + 2 * ch2) = (f32x2){silu_f(s0), silu_f(s1)}; }
        }
    }
    __syncthreads();
    {
        const int rr = ltid >> 1, half = ltid & 1;
        LAS float* rp = (rr < 64 ? qf + rr * 68 : kf + (rr - 64) * 68) + half * 32;
        float v[32]; float ss = 0.f;
#pragma unroll
        for (int i = 0; i < 8; ++i) { const f32x4 t = *(const LAS f32x4*)(rp + 4 * i); v[4 * i] = t[0]; v[4 * i + 1] = t[1]; v[4 * i + 2] = t[2]; v[4 * i + 3] = t[3]; ss += t[0] * t[0] + t[1] * t[1] + t[2] * t[2] + t[3] * t[3]; }
        ss += __shfl_xor(ss, 1);
        const float sc = rsqrtf(ss + 1e-6f);
#pragma unroll
        for (int i = 0; i < 8; ++i) *(LAS f32x4*)(rp + 4 * i) = (f32x4){v[4 * i] * sc, v[4 * i + 1] * sc, v[4 * i + 2] * sc, v[4 * i + 3] * sc};
        if (ltid < 128) {
            const int dd = ltid >> 6, p = ltid & 63, tn = dd ? 63 - p : p;
            const int row = rowbase + c * 64 + tn;
            const float rw = ((const float*)(ws + WS_RROW))[row];
            const float* px = (const float*)(ws + WS_PX) + (size_t)row * 16;
            const float* sw = (const float*)(ws + WS_SW) + (size_t)l * 33 * DIN + (size_t)mrow * DIN + 3840;
            const float braw = px[dd * 4 + h] * rw + sw[dd * 4 + h];
            const float araw = px[8 + dd * 4 + h] * rw + sw[8 + dd * 4 + h];
            const float xs = araw + dt_bias_l[dd * 4 + h];
            const float sp = xs > 20.f ? xs : log1pf(expf(xs));
            beta[dd * 64 + p] = 1.f / (1.f + expf(-braw));
            gg[dd * 64 + p] = -expf(a_log_l[dd * 4 + h]) * sp;
        }
    }
    __syncthreads();
    if (wv == 0) {
#pragma unroll
        for (int dd = 0; dd < 2; ++dd) {
            float v = gg[dd * 64 + lane];
#pragma unroll
            for (int o = 1; o < 64; o <<= 1) { const float t = __shfl_up(v, o); if (lane >= o) v += t; }
            gc[dd * 64 + lane] = v;
            fw[dd * 64 + lane] = beta[dd * 64 + lane] * expf(v);
        }
    }
    __syncthreads();
    const int st0 = seg ? 4 + c : c, st1 = seg ? 4 + (31 - c) : 3 - c;
    unsigned char* rec0 = ws + WS_H + ((size_t)((b * 4 + h) * 2 + 0) * 36 + st0) * GREC;
    unsigned char* rec1 = ws + WS_H + ((size_t)((b * 4 + h) * 2 + 1) * 36 + st1) * GREC;
    {
        const int mt = wv;
        bf16x8 ak[2], aq[2];
#pragma unroll
        for (int ks = 0; ks < 2; ++ks) {
            const LAS float* kp = kf + (mt * 16 + fr) * 68 + ks * 32 + fq * 8; const LAS float* qp = qf + (mt * 16 + fr) * 68 + ks * 32 + fq * 8;
            ak[ks] = pack8(*(const LAS f32x4*)kp, *(const LAS f32x4*)(kp + 4)); aq[ks] = pack8(*(const LAS f32x4*)qp, *(const LAS f32x4*)(qp + 4));
        }
#pragma unroll
        for (int nt = 0; nt < 4; ++nt) {
            bf16x8 bk[2];
#pragma unroll
            for (int ks = 0; ks < 2; ++ks) { const LAS float* kp = kf + (nt * 16 + fr) * 68 + ks * 32 + fq * 8; bk[ks] = pack8(*(const LAS f32x4*)kp, *(const LAS f32x4*)(kp + 4)); }
            f32x4 KK = {0.f, 0.f, 0.f, 0.f}, QK = {0.f, 0.f, 0.f, 0.f};
            KK = MFMA16(ak[0], bk[0], KK); KK = MFMA16(ak[1], bk[1], KK);
            QK = MFMA16(aq[0], bk[0], QK); QK = MFMA16(aq[1], bk[1], QK);
            const int j = nt * 16 + fr;
            const float g0j = gc[j], g1j = gc[64 + 63 - j];
#pragma unroll
            for (int r = 0; r < 4; ++r) {
                const int i = mt * 16 + fq * 4 + r;
                const float g0i = gc[i], g1i = gc[64 + 63 - i];
                if (i > j) Lb[i * 68 + j] = beta[i] * KK[r] * expf(g0i - g0j);
                else if (i < j) Lb[i * 68 + j] = beta[64 + 63 - i] * KK[r] * expf(g1i - g1j);
                const float qv = QK[r] * 0.125f;
                const float a0 = (i >= j) ? qv * expf(g0i - g0j) : 0.f;
                const float a1 = (i <= j) ? qv * expf(g1i - g1j) : 0.f;
                ((bf16_t*)(rec0 + 16384))[i * 64 + pi64(j)] = f2bf(a0);
                ((bf16_t*)(rec1 + 16384))[(63 - i) * 64 + pi64(63 - j)] = f2bf(a1);
            }
        }
#pragma unroll
        for (int it = 0; it < 4; ++it) {
            const int idx = ltid + 256 * it, dd = idx >> 9, rem = idx & 511, rowi = rem >> 3, blk = rem & 7, ks = blk >> 2, q4 = blk & 3;
            unsigned char* rec = dd ? rec1 : rec0;
            {
                const int tn = dd ? 63 - rowi : rowi; const float f = 0.125f * expf(gc[dd * 64 + rowi]);
                const f32x4 v0 = *(const LAS f32x4*)(qf + tn * 68 + 32 * ks + 4 * q4), v1 = *(const LAS f32x4*)(qf + tn * 68 + 32 * ks + 16 + 4 * q4);
                *(bf16x8*)((bf16_t*)(rec + 8192) + rowi * 64 + blk * 8) = pack8(v0 * f, v1 * f);
            }
            {
                const float gl = gc[dd * 64 + 63];
                f32x4 v0, v1;
#pragma unroll
                for (int e = 0; e < 4; ++e) { const int p0 = 32 * ks + 4 * q4 + e, p1 = p0 + 16; const int t0 = dd ? 63 - p0 : p0, t1 = dd ? 63 - p1 : p1;
                    v0[e] = kf[t0 * 68 + rowi] * expf(gl - gc[dd * 64 + p0]); v1[e] = kf[t1 * 68 + rowi] * expf(gl - gc[dd * 64 + p1]); }
                *(bf16x8*)((bf16_t*)(rec + 24576) + rowi * 64 + blk * 8) = pack8(v0, v1);
            }
        }
        if (ltid < 2) { const int dd = ltid; ((float*)(ws + WS_EG))[((b * 4 + h) * 2 + dd) * 36 + (dd ? st1 : st0)] = expf(gc[dd * 64 + 63]); }
    }
    __syncthreads();
    {
        const int dd = wv >> 1, part = wv & 1;
        const LAS float* src = part ? kf : vf;
        const LAS float* fac = part ? fw + dd * 64 : beta + dd * 64;
        if (dd == 0) gdn_solve<0>(Lb, src, fac, lane, part, rec0); else gdn_solve<1>(Lb, src, fac, lane, part, rec1);
    }
    __syncthreads();
}

__device__ __attribute__((noinline)) void gdn_scan_tile(LAS unsigned char* lds, unsigned char* ws, int t, int tid) {
    bf16_t* P = (bf16_t*)(ws + WS_P);
    const int lane = tid & 63, w = tid >> 6, sq = w >> 2, sl = w & 3, fr = lane & 15, fq = lane >> 4, lt = tid & 255;
    const int sid = 2 * t + sq, dd = sid & 1, h = (sid >> 1) & 3, b = sid >> 3;
    const unsigned char* rec0 = ws + WS_H + (size_t)sid * 36 * GREC;
    const float* EG = (const float*)(ws + WS_EG) + sid * 36;
    f32x4 S[4];
#pragma unroll
    for (int i = 0; i < 4; ++i) S[i] = (f32x4){0.f, 0.f, 0.f, 0.f};
    u32x4 pre[8]; u32x2 ut[4], utn[4]; float eg, egn;
#define SC_LOAD(st) do { const unsigned char* rec_ = rec0 + (size_t)(st) * GREC; \
        _Pragma("unroll") for (int i_ = 0; i_ < 8; ++i_) pre[i_] = *(const u32x4*)(rec_ + (size_t)(lt + 256 * i_) * 16); \
        _Pragma("unroll") for (int m_ = 0; m_ < 4; ++m_) utn[m_] = *(const u32x2*)(rec_ + 32768 + ((sl * 16 + fr) * 64 + m_ * 16 + fq * 4) * 2); \
        egn = EG[(st)]; } while (0)
#define SC_STORE(pp) do { _Pragma("unroll") for (int i_ = 0; i_ < 8; ++i_) { const int idx_ = lt + 256 * i_; \
        *(LAS u32x4*)(lds + ((pp) * 2 + sq) * 36864 + (idx_ >> 9) * 9216 + ((idx_ >> 3) & 63) * 144 + (idx_ & 7) * 16) = pre[i_]; } \
        _Pragma("unroll") for (int m_ = 0; m_ < 4; ++m_) ut[m_] = utn[m_]; eg = egn; } while (0)
    SC_LOAD(0); SC_STORE(0); __syncthreads();
    for (int st = 0; st < 36; ++st) {
        if (st + 1 < 36) SC_LOAD(st + 1);
        const LAS unsigned char* B = lds + ((st & 1) * 2 + sq) * 36864;
#define SC_FR(arr, mt, ks) (*(const LAS bf16x8*)(B + (arr) * 9216 + ((mt) * 16 + fr) * 144 + ((ks) * 32 + fq * 8) * 2))
        bf16x8 Sb[2], Vb[2];
        Sb[0] = pack8(S[0], S[1]); Sb[1] = pack8(S[2], S[3]);
        f32x4 av[4], ao[4];
#pragma unroll
        for (int mt = 0; mt < 4; ++mt) { av[mt] = (f32x4){bflo(ut[mt].x), bfhi(ut[mt].x), bflo(ut[mt].y), bfhi(ut[mt].y)};
            av[mt] = MFMA16(SC_FR(0, mt, 0), Sb[0], av[mt]); av[mt] = MFMA16(SC_FR(0, mt, 1), Sb[1], av[mt]); }
        Vb[0] = pack8(av[0], av[1]); Vb[1] = pack8(av[2], av[3]);
#pragma unroll
        for (int mt = 0; mt < 4; ++mt) { ao[mt] = (f32x4){0.f, 0.f, 0.f, 0.f};
            ao[mt] = MFMA16(SC_FR(1, mt, 0), Sb[0], ao[mt]); ao[mt] = MFMA16(SC_FR(1, mt, 1), Sb[1], ao[mt]);
            ao[mt] = MFMA16(SC_FR(2, mt, 0), Vb[0], ao[mt]); ao[mt] = MFMA16(SC_FR(2, mt, 1), Vb[1], ao[mt]); }
#pragma unroll
        for (int mt = 0; mt < 4; ++mt) { f32x4 as = S[mt] * eg;
            as = MFMA16(SC_FR(3, mt, 0), Vb[0], as); as = MFMA16(SC_FR(3, mt, 1), Vb[1], as); S[mt] = as; }
#undef SC_FR
        {
            const int seg = st >= 4, ci = seg ? st - 4 : st;
            const int cn = dd ? (seg ? 31 - ci : 3 - ci) : ci;
            const int rowbase = (seg ? b * SEQL : NLAT + b * CTXL) + cn * 64;
            bf16_t* op = P + (dd ? PC_K : PC_Q) + h * 64 + sl * 16 + fr;
#pragma unroll
            for (int mt = 0; mt < 4; ++mt)
#pragma unroll
                for (int r = 0; r < 4; ++r) { const int p = mt * 16 + fq * 4 + r, tn = dd ? 63 - p : p; op[(size_t)(rowbase + tn) * LDP] = f2bf(ao[mt][r]); }
        }
        if (st + 1 < 36) SC_STORE((st + 1) & 1);
        __syncthreads();
    }
#undef SC_LOAD
#undef SC_STORE
}


__device__ __forceinline__ void gemm_in_phase(LAS unsigned char* lds, unsigned char* ws, int l, int G, int bx, int wid) {
    float* sWl = (float*)(ws + WS_SW) + (size_t)l * 33 * DIN;
    pg8::Gemm g{(const bf16_t*)(ws + WS_H), (const bf16_t*)(ws + WS_WIN) + (size_t)l * 3840 * 1024, NT, NPJ, 1024, 1024, 0};
    pg8::StaticOrder S; S.init(NT, NPJ, G, bx);
    EpiP E{(bf16_t*)(ws + WS_P), (bf16_t*)(ws + WS_VT), (const float*)(ws + WS_RROW), sWl, (const f32x2*)(ws + WS_ROPE)};
    pg8::gemm_phase<EpiP>(lds, g, S, E, wid);
}
__device__ __forceinline__ void gemm_out_phase(LAS unsigned char* lds, unsigned char* ws, int l, int G, int bx, const float* xlat, const float* xctx, float* out, int wid) {
    const float* modl = (const float*)(ws + WS_MOD) + (size_t)l * 33 * 3072;
    const int M = l ? NLAT : NT;
    pg8::Gemm g{(const bf16_t*)(ws + WS_P), (const bf16_t*)(ws + WS_WOUT) + (size_t)l * 1024 * 1024, M, 1024, 1024, LDP, 1};
    pg8::StaticOrder S; S.init(M, 1024, G, bx);
    EpiRes E{xlat, xctx, out, (float*)(ws + WS_XC1), modl + 2048};
    pg8::gemm_phase<EpiRes>(lds, g, S, E, wid);
}


__device__ __attribute__((noinline)) float compute_lam(const float* lf, float lam_init, int tid) {
    const int ln = tid & 63;
    float p1 = lf[ln] * lf[64 + ln], p2 = lf[128 + ln] * lf[192 + ln];
#pragma unroll
    for (int o = 32; o >= 1; o >>= 1) { p1 += __shfl_xor(p1, o); p2 += __shfl_xor(p2, o); }
    return expf(p1) - expf(p2) + lam_init;
}
__device__ __attribute__((noinline)) void gdn_finish_phase(unsigned char* ws, const float* cw, int nrows, int vb, int G, int tid) {
    bf16_t* P = (bf16_t*)(ws + WS_P);
    for (size_t idx = (size_t)vb * NTHREADS + tid; idx < (size_t)nrows * 32; idx += (size_t)G * NTHREADS) {
        const int row = (int)(idx >> 5), hg = (int)(idx & 31), h = hg >> 3, part = hg & 7;
        bf16_t* pr = P + (size_t)row * LDP + h * 64 + part * 8;
#if EN_C
        const u32x4 of = *(const u32x4*)(pr + PC_Q), ob = *(const u32x4*)(pr + PC_K), zz = *(const u32x4*)(pr + PC_Z);
        float o[8];
        o[0] = bflo(of.x) + bflo(ob.x); o[1] = bfhi(of.x) + bfhi(ob.x); o[2] = bflo(of.y) + bflo(ob.y); o[3] = bfhi(of.y) + bfhi(ob.y);
        o[4] = bflo(of.z) + bflo(ob.z); o[5] = bfhi(of.z) + bfhi(ob.z); o[6] = bflo(of.w) + bflo(ob.w); o[7] = bfhi(of.w) + bfhi(ob.w);
        float ss = 0.f;
#pragma unroll
        for (int e = 0; e < 8; ++e) ss += o[e] * o[e];
        ss += __shfl_xor(ss, 1); ss += __shfl_xor(ss, 2); ss += __shfl_xor(ss, 4);
        const float rr = rsqrtf(ss * (1.f / 64.f) + 1e-6f);
        const f32x4 w0 = *(const f32x4*)(cw + part * 8), w1 = *(const f32x4*)(cw + part * 8 + 4);
        u32x4 y;
        y.x = pk2(o[0] * rr * w0[0] * silu_f(bflo(zz.x)), o[1] * rr * w0[1] * silu_f(bfhi(zz.x)));
        y.y = pk2(o[2] * rr * w0[2] * silu_f(bflo(zz.y)), o[3] * rr * w0[3] * silu_f(bfhi(zz.y)));
        y.z = pk2(o[4] * rr * w1[0] * silu_f(bflo(zz.z)), o[5] * rr * w1[1] * silu_f(bfhi(zz.z)));
        y.w = pk2(o[6] * rr * w1[2] * silu_f(bflo(zz.w)), o[7] * rr * w1[3] * silu_f(bfhi(zz.w)));
        *(u32x4*)(pr + PC_Z) = y;
#else
        *(u32x4*)(pr + PC_Z) = (u32x4){0u, 0u, 0u, 0u};
#endif
#if !EN_A
        *(u32x4*)(P + (size_t)row * LDP + PA_U + hg * 8) = (u32x4){0u, 0u, 0u, 0u};
#endif
#if !EN_B
        *(u32x4*)(P + (size_t)row * LDP + PB_Z + hg * 8) = (u32x4){0u, 0u, 0u, 0u};
        *(u32x4*)(P + (size_t)row * LDP + PB_Z + 256 + hg * 8) = (u32x4){0u, 0u, 0u, 0u};
#endif
    }
}
__device__ __attribute__((noinline)) void final_norm_phase(float* out, const float* fnw, int vb, int G, int tid) {
    const int lane = tid & 63, w = tid >> 6;
    f32x4 fw4[4];
#pragma unroll
    for (int j = 0; j < 4; ++j) fw4[j] = *(const f32x4*)(fnw + j * 256 + lane * 4);
    for (int row = vb * 8 + w; row < NLAT; row += G * 8) {
        float* xr = out + (size_t)row * DM;
        f32x4 v[4]; float ss = 0.f;
#pragma unroll
        for (int j = 0; j < 4; ++j) { v[j] = *(const f32x4*)(xr + j * 256 + lane * 4); ss += v[j][0] * v[j][0] + v[j][1] * v[j][1] + v[j][2] * v[j][2] + v[j][3] * v[j][3]; }
#pragma unroll
        for (int o = 32; o >= 1; o >>= 1) ss += __shfl_xor(ss, o);
        const float rr = rsqrtf(ss * (1.f / 1024.f) + 1e-6f);
#pragma unroll
        for (int j = 0; j < 4; ++j) *(f32x4*)(xr + j * 256 + lane * 4) = v[j] * rr * fw4[j];
    }
}

__global__ void __launch_bounds__(NTHREADS, 2) fwd_mega(KArgs a) {
    extern __shared__ __attribute__((aligned(16))) unsigned char lds_raw[];
    LAS unsigned char* lds = (LAS unsigned char*)lds_raw;
    cg::grid_group grid = cg::this_grid();
    const int wid_s = __builtin_amdgcn_readfirstlane((int)threadIdx.x >> 6);
    const int G = gridDim.x, bx = blockIdx.x;
#define TID() (wid_s * 64 + lane_id_v())
    const int vb = (G % 8 == 0) ? (bx % 8) * (G / 8) + bx / 8 : bx;
    unsigned char* ws0 = a.ws;
    const int lo = a.ph_lo, hi = a.ph_hi;
    int ph = 0;
#define PHASE_BEGIN if (ph >= lo && ph < hi) { unsigned char* ws = ws0; asm volatile("" : "+s"(ws));
#define PHASE_END   if (ph + 1 < hi) { __builtin_amdgcn_fence(__ATOMIC_RELEASE, "agent"); grid.sync(); __builtin_amdgcn_fence(__ATOMIC_ACQUIRE, "agent"); asm volatile("s_waitcnt vmcnt(0)" ::: "memory"); } } ++ph;

    PHASE_BEGIN
        for (int t = vb; t < 2536; t += G) {
            if (t < 96) { const int l = t / 48, n0 = (t % 48) * 64;
                small33(lds, a.c, 1024, a.c_ctx, true, a.w_ada + (size_t)l * 1024 * 3072, 3072, 3072, n0, a.b_ada + l * 3072, (float*)(ws + WS_MOD) + (size_t)l * 33 * 3072, 3072, TID());
            } else if (t < 96 + 1920) { const int u = t - 96, l = u / 960, r = u % 960, kt = r / 60, nt = r % 60;
                tconv_tile(lds, a.w_in + (size_t)l * 1024 * DIN, DIN, (bf16_t*)(ws + WS_WIN) + (size_t)l * 3840 * 1024, 1024, kt * 64, nt * 64, TID());
            } else if (t < 96 + 1920 + 512) { const int u = t - 2016, l = u / 256, r = u % 256, kt = r / 16, nt = r % 16;
                tconv_tile(lds, a.w_out + (size_t)l * 1024 * 1024, 1024, (bf16_t*)(ws + WS_WOUT) + (size_t)l * 1024 * 1024, 1024, kt * 64, nt * 64, TID());
            } else { const int mi = t - 2528; const int tid = TID();
                for (int i = mi * 512 + tid; i < 1024; i += 8 * 512) { const int pos = i >> 4, ii = i & 15;
                    const float invf = powf(10000.f, -(float)(2 * ii) / 32.f); const float ang = (float)pos * invf;
                    ((f32x2*)(ws + WS_ROPE))[i] = (f32x2){cosf(ang), sinf(ang)}; }
                for (int i = mi * 512 + tid; i < 2 * 16 * 1024; i += 8 * 512) { const int l = i >> 14, j = (i >> 10) & 15, k = i & 1023;
                    ((bf16_t*)(ws + WS_WX))[i] = f2bf(a.w_in[(size_t)l * 1024 * DIN + (size_t)k * DIN + 3840 + j]); }
                for (int i = mi * 512 + tid; i < 2 * 4 * 128 * 128; i += 8 * 512) ((bf16_t*)(ws + WS_AWS))[i] = f2bf(a.a_ws[i]);
            }
        }
    PHASE_END

    for (int l = 0; l < 2; ++l) {
#define XLAT (l ? (const float*)a.out : a.x)
#define XCTX (l ? (const float*)(ws + WS_XC1) : a.ctx)
#define MODL ((const float*)(ws + WS_MOD) + (size_t)l * 33 * 3072)
#define SWL ((float*)(ws + WS_SW) + (size_t)l * 33 * DIN)
        PHASE_BEGIN
            for (int t = vb; t < 61 + 576; t += G) {
                if (t < 61) small33(lds, MODL, 3072, MODL + 32 * 3072, false, a.w_in + (size_t)l * 1024 * DIN, DIN, DIN, t * 64, nullptr, SWL, DIN, TID());
                else panel_tile(lds, ws, a.norm_w + l * 1024, l, t - 61, XLAT, XCTX, TID());
            }
        PHASE_END
        PHASE_BEGIN
            gemm_in_phase(lds, ws, l, G, bx, wid_s);
        PHASE_END
        PHASE_BEGIN
            const float lam_init = 0.8f - 0.6f * expf(-0.3f * (float)l);
            const float lam = compute_lam(a.b_lam + l * 256, lam_init, TID());
            const int nBl = 2048, nCp = 2304, nA = l ? 512 : 576, nBc = l ? 0 : 256;
            for (int t = vb; t < nBl + nCp + nA + nBc; t += G) {
                if (t < nBl) {
#if EN_B
                    const int b = t >> 6, h = (t >> 4) & 3, qb = t & 15;
                    attn_tile(lds, ws, a.b_subln_w + l * 128, b, h, b * SEQL + qb * 128, 36, lam, 1.f - lam_init, wid_s);
#endif
                } else if (t < nBl + nCp) {
#if EN_C
                    int u = t - nBl; const int hp = u & 1; u >>= 1; const int b = u / 36, cc = u % 36, seg = cc >= 4, c = seg ? cc - 4 : cc;
                    gdn_prep_tile(lds, ws, a.c_conv_w + (size_t)l * 5 * 768, a.c_a_log + l * 8, a.c_dt_bias + l * 8, l, b, seg, c, hp, TID());
#endif
                } else if (t < nBl + nCp + nA) {
#if EN_A
                    const int u = t - nBl - nCp;
                    const int R0 = u < 512 ? (u >> 4) * SEQL + (u & 15) * 128 : NLAT + ((u - 512) >> 1) * CTXL + ((u - 512) & 1) * 128;
                    gmlp_tile(lds, ws, a.a_ln_w + l * 256, a.a_bs + l * 512, l, R0, TID());
#endif
                } else {
#if EN_B
                    const int u = t - nBl - nCp - nA, b = u >> 3, h = (u >> 1) & 3, qb = u & 1;
                    attn_tile(lds, ws, a.b_subln_w + l * 128, b, h, NLAT + b * CTXL + qb * 128, 4, lam, 1.f - lam_init, wid_s);
#endif
                }
            }
        PHASE_END
        PHASE_BEGIN
#if EN_C
            for (int t = vb; t < 128; t += G) gdn_scan_tile(lds, ws, t, TID());
#endif
        PHASE_END
        PHASE_BEGIN
            gdn_finish_phase(ws, a.c_norm_w + l * 64, l ? NLAT : NT, vb, G, TID());
        PHASE_END
        PHASE_BEGIN
            gemm_out_phase(lds, ws, l, G, bx, XLAT, XCTX, a.out, wid_s);
        PHASE_END
    }
    PHASE_BEGIN
        final_norm_phase(a.out, a.final_norm_w, vb, G, TID());
    PHASE_END
#undef PHASE_BEGIN
#undef PHASE_END
}

constexpr int N_PHASES = 14;

extern "C" void kernel_launch(void* const* d_in, const int* in_sizes, int n_in, void* d_out, int out_size, void* d_ws, size_t ws_size, hipStream_t stream) {
    static int grid = 0;
    if (grid == 0) {
        int dev = 0, cus = 0, per_cu = 0;
        (void)hipGetDevice(&dev);
        (void)hipDeviceGetAttribute(&cus, hipDeviceAttributeMultiprocessorCount, dev);
        if (hipFuncSetAttribute((const void*)fwd_mega, hipFuncAttributeMaxDynamicSharedMemorySize, LDS_BYTES) != hipSuccess) fprintf(stderr, "hipFuncSetAttribute failed\n");
        if (hipOccupancyMaxActiveBlocksPerMultiprocessor(&per_cu, (const void*)fwd_mega, NTHREADS, LDS_BYTES) != hipSuccess || per_cu < 1) { fprintf(stderr, "occupancy query: %d\n", per_cu); per_cu = 1; }
        (void)hipGetLastError();
        grid = cus;
        if (ws_size < WS_END) fprintf(stderr, "workspace too small: %zu < %zu\n", ws_size, (size_t)WS_END);
    }
    KArgs a{};
    a.x = (const float*)d_in[0]; a.c = (const float*)d_in[1]; a.ctx = (const float*)d_in[2]; a.c_ctx = (const float*)d_in[3];
    a.w_ada = (const float*)d_in[4]; a.b_ada = (const float*)d_in[5]; a.norm_w = (const float*)d_in[6]; a.w_in = (const float*)d_in[7];
    a.w_out = (const float*)d_in[8]; a.a_ln_w = (const float*)d_in[9]; a.a_ws = (const float*)d_in[10]; a.a_bs = (const float*)d_in[11];
    a.b_lam = (const float*)d_in[12]; a.b_subln_w = (const float*)d_in[13]; a.c_conv_w = (const float*)d_in[14]; a.c_a_log = (const float*)d_in[15];
    a.c_dt_bias = (const float*)d_in[16]; a.c_norm_w = (const float*)d_in[17]; a.final_norm_w = (const float*)d_in[18];
    a.out = (float*)d_out; a.ws = (unsigned char*)d_ws;
#if SINGLE_LAUNCH
    a.ph_lo = 0; a.ph_hi = N_PHASES;
    void* args[] = {&a};
    hipError_t e = hipLaunchCooperativeKernel((const void*)fwd_mega, dim3(grid), dim3(NTHREADS), args, LDS_BYTES, stream);
    if (e != hipSuccess) fprintf(stderr, "cooperative launch failed: %s (grid %d)\n", hipGetErrorString(e), grid);
#else
    for (int p = 0; p < N_PHASES; ++p) {
        a.ph_lo = p; a.ph_hi = p + 1;
        void* args[] = {&a};
        hipError_t e = hipLaunchCooperativeKernel((const void*)fwd_mega, dim3(grid), dim3(NTHREADS), args, LDS_BYTES, stream);
        if (e != hipSuccess) { fprintf(stderr, "launch %d failed: %s\n", p, hipGetErrorString(e)); break; }
    }
#endif
}
```

```cpp
#include <hip/hip_runtime.h>
#include <hip/hip_cooperative_groups.h>
#include <cstdio>
namespace cg = cooperative_groups;

#ifndef SINGLE_LAUNCH
#define SINGLE_LAUNCH 1
#endif
#ifndef TPROBE
#define TPROBE -1
#endif
#ifndef EN_A
#define EN_A 1
#endif
#ifndef EN_B
#define EN_B 1
#endif
#ifndef EN_C
#define EN_C 1
#endif

#define LAS __attribute__((address_space(3)))
#define GAS __attribute__((address_space(1)))
typedef unsigned short bf16_t;
typedef short bf16x8 __attribute__((ext_vector_type(8)));
typedef float f32x4 __attribute__((ext_vector_type(4)));
typedef float f32x2 __attribute__((ext_vector_type(2)));
typedef float f32x16 __attribute__((ext_vector_type(16)));
typedef unsigned u32x4 __attribute__((ext_vector_type(4)));
typedef unsigned u32x2 __attribute__((ext_vector_type(2)));

constexpr int DM = 1024, NBATCH = 32, SEQL = 2048, CTXL = 256;
constexpr int NLAT = NBATCH * SEQL, NCTX = NBATCH * CTXL, NT = NLAT + NCTX;
constexpr int DIN = 3856, NPJ = 3840, LDP = 3328;
constexpr int PA_U = 0, PA_V = 256, PA_Z = 512, PB_Q = 768, PB_K = 1280, PB_Z = 1792, PC_Q = 2304, PC_K = 2560, PC_V = 2816, PC_Z = 3072;
constexpr int LDS_BYTES = 147456;
constexpr int NTHREADS = 512;

constexpr size_t al256(size_t x) { return (x + 255) & ~(size_t)255; }
constexpr size_t WS_MOD = 0;
constexpr size_t WS_SW = WS_MOD + 2ull * 33 * 3072 * 4;
constexpr size_t WS_ROPE = al256(WS_SW + 2ull * 33 * 3856 * 4);
constexpr size_t WS_WX = WS_ROPE + 8192;
constexpr size_t WS_AWS = WS_WX + 65536;
constexpr size_t WS_RROW = WS_AWS + 262144;
constexpr size_t WS_EG = WS_RROW + (size_t)NT * 4;
constexpr size_t WS_PX = WS_EG + 36864;
constexpr size_t WS_WIN = WS_PX + (size_t)NT * 64;
constexpr size_t WS_WOUT = WS_WIN + 2ull * 3840 * 1024 * 2;
constexpr size_t WS_XC1 = WS_WOUT + 2ull * 1024 * 1024 * 2;
constexpr size_t WS_VT = WS_XC1 + (size_t)NCTX * 1024 * 4;
constexpr size_t WS_P = WS_VT + 32ull * 4 * 128 * 2304 * 2;
constexpr size_t WS_H = WS_P + (size_t)NT * LDP * 2;
constexpr size_t GREC = 40960;
constexpr size_t WS_END = WS_H + 9216ull * GREC;
constexpr size_t WS_TS = WS_END;
static_assert(WS_END + 256 <= (1ull << 30), "workspace");
static_assert((WS_SW % 256) == 0 && (WS_WIN % 256) == 0 && (WS_P % 256) == 0 && (WS_H % 256) == 0 && (WS_VT % 256) == 0 && (WS_PX % 256) == 0, "align");

struct KArgs {
    const GAS float *x, *c, *ctx, *c_ctx, *w_ada, *b_ada, *norm_w, *w_in, *w_out, *a_ln_w, *a_ws, *a_bs, *b_lam, *b_subln_w, *c_conv_w, *c_a_log, *c_dt_bias, *c_norm_w, *final_norm_w;
    GAS float* out; GAS unsigned char* ws; int ph_lo, ph_hi;
};

typedef __bf16 bf16v2 __attribute__((ext_vector_type(2)));
__device__ __forceinline__ unsigned pk2(float lo, float hi) { const f32x2 v = {lo, hi}; const bf16v2 b = __builtin_convertvector(v, bf16v2); return __builtin_bit_cast(unsigned, b); }
__device__ __forceinline__ float bflo(unsigned u) { return __uint_as_float(u << 16); }
__device__ __forceinline__ float bfhi(unsigned u) { return __uint_as_float(u & 0xffff0000u); }
__device__ __forceinline__ bf16_t f2bf(float f) { return (bf16_t)(pk2(f, 0.f) & 0xffffu); }
__device__ __forceinline__ bf16x8 pack8(f32x4 a, f32x4 b) { u32x4 r; r.x = pk2(a[0], a[1]); r.y = pk2(a[2], a[3]); r.z = pk2(b[0], b[1]); r.w = pk2(b[2], b[3]); return __builtin_bit_cast(bf16x8, r); }
__device__ __forceinline__ float fexp(float v) { return __builtin_amdgcn_exp2f(v * 1.44269504088896f); }
__device__ __forceinline__ float silu_f(float v) { return v * __builtin_amdgcn_rcpf(1.f + fexp(-v)); }
__device__ __forceinline__ int pi64(int x) { return (x & 32) | ((x & 12) << 1) | ((x & 16) >> 2) | (x & 3); }
__device__ __forceinline__ int lane_id_v() { int l; asm volatile("v_mbcnt_lo_u32_b32 %0, -1, 0\n\tv_mbcnt_hi_u32_b32 %0, -1, %0" : "=v"(l)); return l; }
__device__ __forceinline__ float shfl_x32(float v, int lane) { return __int_as_float(__builtin_amdgcn_ds_bpermute((lane ^ 32) << 2, __float_as_int(v))); }
#define ASSUME_GLOBAL(p) do { __builtin_assume(!__builtin_amdgcn_is_shared((const void*)(p))); __builtin_assume(!__builtin_amdgcn_is_private((const void*)(p))); } while (0)
#define MFMA16(a, b, c) __builtin_amdgcn_mfma_f32_16x16x32_bf16((a), (b), (c), 0, 0, 0)
#define MFMA32(a, b, c) __builtin_amdgcn_mfma_f32_32x32x16_bf16((a), (b), (c), 0, 0, 0)

namespace pg8 {
constexpr int BM = 256, BK = 64, HALF = 128, HTB = HALF * BK * 2, STAGE_BYTES = 8 * HTB, NXCD = 8, WGM = 8;
__host__ __device__ __forceinline__ int lds_byte(int r, int c) { const int st = (r >> 4) * 2 + (c >> 5), rr = r & 15, cc = c & 31, ob = rr * 64 + cc * 2; return st * 1024 + (ob ^ (((ob >> 9) & 1) << 5)); }
__host__ __device__ __forceinline__ void stage_rc(int b, int& R, int& C) { const int st = b / 1024, sb = b % 1024, swz = sb ^ (((sb >> 9) & 1) << 5); R = (st >> 1) * 16 + swz / 64; C = (st & 1) * 32 + (swz % 64) / 2; }
__host__ __device__ __forceinline__ int perm32(int rho) { const int n = rho >> 4, i = rho & 15; return 8 * (i >> 2) + 4 * n + (i & 3); }
struct Unit { int pm, pn; };
struct Gemm { const GAS bf16_t* A; const GAS bf16_t* Bt; int M, N, K, lda, seg; };
struct StaticOrder {
    int nM, nN, nwg, G, c, nextra;
    __device__ void init(int M, int N, int G_, int c_) { nM = M / BM; nN = N / BM; nwg = nM * nN; G = G_; c = c_; nextra = 0; }
    __device__ bool next(int i, Unit& u) const {
        const long L = (long)i * G + c; if (L >= nwg + nextra) return false;
        if (L >= nwg) { const int j = (int)(L - nwg), k = j % 7; u.pm = nM + j / 7; u.pn = k < 4 ? 5 + k : 7 + k; return true; }
        int wgid = (int)L; { const int q = nwg / NXCD, r = nwg % NXCD, xcd = wgid % NXCD, off = wgid / NXCD; wgid = (xcd < r ? xcd * (q + 1) : r * (q + 1) + (xcd - r) * q) + off; }
        const int nig = WGM * nN, gid = wgid / nig, fm = gid * WGM, gsz = (nM - fm) < WGM ? (nM - fm) : WGM;
        u.pm = fm + ((wgid % nig) % gsz); u.pn = (wgid % nig) / gsz; return true;
    }
};
__device__ __forceinline__ size_t akb(int seg, int t) { return seg ? (size_t)(t < 4 ? t * 64 : (t < 12 ? PB_Z + (t - 4) * 64 : PC_Z + (t - 12) * 64)) * 2 : (size_t)t * 128; }

template <class Epi>
__device__ __forceinline__ void gemm_phase(LAS unsigned char* lds, const Gemm g, const StaticOrder& S, const Epi& E, int wid) {
    const int lane = lane_id_v(), tid = wid * 64 + lane, wr = wid >> 2, wc = wid & 3, fr = lane & 15, fq = lane >> 4;
    const int K = g.K, nt = K / BK, lda = g.lda, seg = g.seg;
    unsigned voffA[2], voffB[2];
#pragma unroll
    for (int i = 0; i < 2; ++i) { int R, C; stage_rc(tid * 16 + i * 8192, R, C); const int Rb = Epi::PERM ? ((R & ~31) + perm32(R & 31)) : R;
        voffA[i] = (unsigned)(R * lda + C) * 2u; voffB[i] = (unsigned)(Rb * K + C) * 2u; }
    const size_t kstep = (size_t)(BK * 2);
    const size_t hstepA = (size_t)HALF * lda * 2, hstepB = (size_t)HALF * K * 2;
    const size_t tstepA = 2 * hstepA, tstepB = 2 * hstepB;
    const unsigned ldsw = (unsigned)wid * 1024u;
    const int aoff = lds_byte(wr * 64 + fr, fq * 8), boff = lds_byte(wc * 32 + fr, fq * 8);
#define PG8_SA(b, h) (((b) * 2 + (h)) * HTB)
#define PG8_SB(b, h) ((4 + (b) * 2 + (h)) * HTB)
#define PG8_STAGE(bufoff, gbase, voff) do { _Pragma("unroll") for (int _i = 0; _i < 2; ++_i) \
        __builtin_amdgcn_global_load_lds((const GAS unsigned*)((const GAS char*)(gbase) + (voff)[_i]), (LAS unsigned*)(lds + (bufoff) + ldsw + _i * 8192), 16, 0, 0); } while (0)
#define PG8_LDA(dst, b, h) do { _Pragma("unroll") for (int m = 0; m < 4; ++m) _Pragma("unroll") for (int k = 0; k < 2; ++k) dst[m][k] = *(const LAS bf16x8*)(lds + PG8_SA(b, h) + aoff + m * 2048 + k * 1024); } while (0)
#define PG8_LDB(dst, b, h) do { _Pragma("unroll") for (int n = 0; n < 2; ++n) _Pragma("unroll") for (int k = 0; k < 2; ++k) dst[n][k] = *(const LAS bf16x8*)(lds + PG8_SB(b, h) + boff + n * 2048 + k * 1024); } while (0)
#define PG8_MMA(ai, bj, At, Bt) do { __builtin_amdgcn_s_setprio(1); _Pragma("unroll") for (int m = 0; m < 4; ++m) _Pragma("unroll") for (int n = 0; n < 2; ++n) _Pragma("unroll") for (int k = 0; k < 2; ++k) \
        acc[ai][bj][m][n] = __builtin_amdgcn_mfma_f32_16x16x32_bf16(Bt[n][k], At[m][k], acc[ai][bj][m][n], 0, 0, 0); __builtin_amdgcn_s_setprio(0); } while (0)
#define PG8_WAIT_V(n) asm volatile("s_waitcnt vmcnt(" #n ")" ::: "memory")
#define PG8_WAIT_L(n) asm volatile("s_waitcnt lgkmcnt(" #n ")" ::: "memory")
#define PG8_BAR __builtin_amdgcn_s_barrier()
#define PG8_SCHED __builtin_amdgcn_sched_barrier(0)
    Unit cur, nxt; int ui = 0;
    if (!S.next(0, cur)) return;
    f32x4 acc[2][2][4][2];
#pragma unroll
    for (int a = 0; a < 2; ++a)
#pragma unroll
        for (int b = 0; b < 2; ++b)
#pragma unroll
            for (int m = 0; m < 4; ++m)
#pragma unroll
                for (int n = 0; n < 2; ++n) acc[a][b][m][n] = (f32x4){0.f, 0.f, 0.f, 0.f};
    bf16x8 At[4][2], B0[2][2], B1[2][2];
    const GAS char* cA = (const GAS char*)g.A + (size_t)cur.pm * tstepA; const GAS char* cB = (const GAS char*)g.Bt + (size_t)cur.pn * tstepB;
    PG8_STAGE(PG8_SB(0, 0), cB, voffB); PG8_STAGE(PG8_SA(0, 0), cA + akb(seg, 0), voffA); PG8_STAGE(PG8_SB(0, 1), cB + hstepB, voffB); PG8_STAGE(PG8_SA(0, 1), cA + akb(seg, 0) + hstepA, voffA);
    if (wr == 1) PG8_BAR;
    PG8_WAIT_V(4); PG8_BAR;
    PG8_STAGE(PG8_SB(1, 0), cB + kstep, voffB); PG8_STAGE(PG8_SA(1, 0), cA + akb(seg, 1), voffA); PG8_STAGE(PG8_SB(1, 1), cB + hstepB + kstep, voffB);
    PG8_WAIT_V(6); PG8_BAR;
    for (;;) {
        const bool has_next = S.next(ui + 1, nxt);
        const GAS char* nA = has_next ? (const GAS char*)g.A + (size_t)nxt.pm * tstepA : cA; const GAS char* nB = has_next ? (const GAS char*)g.Bt + (size_t)nxt.pn * tstepB : cB;
        for (int t = 0; t < nt; t += 2) {
            const bool last = (t == nt - 2);
            const GAS char* a1 = cA + akb(seg, t + 1);
            const GAS char* a2 = last ? nA + akb(seg, 0) : cA + akb(seg, t + 2); const GAS char* b2 = last ? nB : cB + (size_t)(t + 2) * kstep;
            const GAS char* a3 = last ? nA + akb(seg, 1) : cA + akb(seg, t + 3); const GAS char* b3 = b2 + kstep;
            PG8_LDB(B0, 0, 0); PG8_SCHED; PG8_LDA(At, 0, 0); PG8_STAGE(PG8_SA(1, 1), a1 + hstepA, voffA);
            PG8_WAIT_L(8); PG8_BAR; PG8_WAIT_L(0); PG8_MMA(0, 0, At, B0); PG8_BAR; PG8_SCHED;
            PG8_LDB(B1, 0, 1); PG8_STAGE(PG8_SB(0, 0), b2, voffB);
            PG8_BAR; PG8_WAIT_L(0); PG8_MMA(0, 1, At, B1); PG8_BAR;
            PG8_LDA(At, 0, 1); PG8_STAGE(PG8_SA(0, 0), a2, voffA);
            PG8_BAR; PG8_WAIT_L(0); PG8_MMA(1, 0, At, B0); PG8_BAR; PG8_SCHED;
            PG8_STAGE(PG8_SB(0, 1), b2 + hstepB, voffB);
            PG8_WAIT_V(6); PG8_BAR; PG8_MMA(1, 1, At, B1); PG8_BAR;
            PG8_LDB(B0, 1, 0); PG8_SCHED; PG8_LDA(At, 1, 0); PG8_STAGE(PG8_SA(0, 1), a2 + hstepA, voffA);
            PG8_WAIT_L(8); PG8_BAR; PG8_WAIT_L(0); PG8_MMA(0, 0, At, B0); PG8_BAR; PG8_SCHED;
            PG8_LDB(B1, 1, 1); PG8_STAGE(PG8_SB(1, 0), b3, voffB);
            PG8_BAR; PG8_WAIT_L(0); PG8_MMA(0, 1, At, B1); PG8_BAR;
            PG8_LDA(At, 1, 1); PG8_STAGE(PG8_SA(1, 0), a3, voffA);
            PG8_BAR; PG8_WAIT_L(0); PG8_MMA(1, 0, At, B0); PG8_BAR; PG8_SCHED;
            PG8_STAGE(PG8_SB(1, 1), b3 + hstepB, voffB);
            PG8_WAIT_V(6); PG8_BAR; PG8_MMA(1, 1, At, B1); PG8_BAR;
        }
        E(acc, cur, wr, wc, fr, fq);
        if (!has_next) break;
#pragma unroll
        for (int a = 0; a < 2; ++a)
#pragma unroll
            for (int b = 0; b < 2; ++b)
#pragma unroll
                for (int m = 0; m < 4; ++m)
#pragma unroll
                    for (int n = 0; n < 2; ++n) acc[a][b][m][n] = (f32x4){0.f, 0.f, 0.f, 0.f};
        cur = nxt; cA = nA; cB = nB; ++ui;
    }
    PG8_WAIT_V(0);
    if (wr == 0) PG8_BAR;
    PG8_BAR;
#undef PG8_SA
#undef PG8_SB
#undef PG8_STAGE
#undef PG8_LDA
#undef PG8_LDB
#undef PG8_MMA
#undef PG8_WAIT_V
#undef PG8_WAIT_L
#undef PG8_BAR
#undef PG8_SCHED
}
}

struct EpiP {
    static constexpr bool PERM = true;
    GAS bf16_t* P; GAS bf16_t* VT; const GAS float* rrow; const GAS float* sW; const GAS f32x2* rope;
    __device__ __forceinline__ void operator()(const f32x4 (&acc)[2][2][4][2], const pg8::Unit& u, int wr, int wc, int fr, int fq) const {
        const int lane = lane_id_v();
        const int row0 = u.pm * 256 + wr * 64 + fr;
        const bool lat = u.pm < 256;
        const int mrow = lat ? (u.pm >> 3) : 32;
        const int pn = u.pn;
        const int ocol0 = pn * 256 + wc * 32 + 8 * fq;
        const int pcol0 = (pn < 7 ? pn * 256 : (pn - 2) * 256) + wc * 32 + 8 * fq;
        const bool do_rope = lat && pn >= 3 && pn <= 6;
        const bool is_v = (pn == 7 || pn == 8);
        f32x4 bv[2][2];
#pragma unroll
        for (int bj = 0; bj < 2; ++bj)
#pragma unroll
            for (int n = 0; n < 2; ++n) bv[bj][n] = *(const GAS f32x4*)(sW + (size_t)mrow * DIN + ocol0 + bj * 128 + 4 * n);
        float rrv[2][4];
#pragma unroll
        for (int ai = 0; ai < 2; ++ai)
#pragma unroll
            for (int m = 0; m < 4; ++m) rrv[ai][m] = rrow[row0 + ai * 128 + m * 16];
#pragma unroll
        for (int ai = 0; ai < 2; ++ai)
#pragma unroll
            for (int m = 0; m < 4; ++m) {
                const int row = row0 + ai * 128 + m * 16;
                const float rr = rrv[ai][m];
#pragma unroll
                for (int bj = 0; bj < 2; ++bj) {
                    f32x4 v0 = acc[ai][bj][m][0] * rr + bv[bj][0], v1 = acc[ai][bj][m][1] * rr + bv[bj][1];
                    if (do_rope) {
                        const int t = row & 2047;
                        const int pos = (wc & 1) ? (t & 63) : (t >> 6);
                        const GAS f32x4* tp = (const GAS f32x4*)(rope + pos * 16 + 8 * (fq & 1));
                        const f32x4 t0 = tp[0], t1 = tp[1], t2 = tp[2], t3 = tp[3];
                        const float sg = (fq >= 2) ? 1.f : -1.f;
                        f32x4 p0, p1;
#pragma unroll
                        for (int e = 0; e < 4; ++e) { p0[e] = shfl_x32(v0[e], lane); p1[e] = shfl_x32(v1[e], lane); }
                        v0[0] = v0[0] * t0[0] + sg * p0[0] * t0[1]; v0[1] = v0[1] * t0[2] + sg * p0[1] * t0[3];
                        v0[2] = v0[2] * t1[0] + sg * p0[2] * t1[1]; v0[3] = v0[3] * t1[2] + sg * p0[3] * t1[3];
                        v1[0] = v1[0] * t2[0] + sg * p1[0] * t2[1]; v1[1] = v1[1] * t2[2] + sg * p1[1] * t2[3];
                        v1[2] = v1[2] * t3[0] + sg * p1[2] * t3[1]; v1[3] = v1[3] * t3[2] + sg * p1[3] * t3[3];
                    }
                    if (is_v) {
                        const int hh = 2 * (pn - 7) + bj;
                        int bb, key;
                        if (lat) { bb = row >> 11; key = 256 + (row & 2047); } else { const int rc = row - NLAT; bb = rc >> 8; key = rc & 255; }
                        const int kx = key & 15;
                        const int kp = (key & ~15) | (kx & 3) | ((kx & 4) << 1) | ((kx & 8) >> 1);
                        GAS bf16_t* vp = VT + ((size_t)(bb * 4 + hh) * 128 + wc * 32 + 8 * fq) * 2304 + kp;
#pragma unroll
                        for (int e = 0; e < 4; ++e) { vp[(size_t)e * 2304] = f2bf(v0[e]); vp[(size_t)(4 + e) * 2304] = f2bf(v1[e]); }
                    } else {
                        u32x4 w; w.x = pk2(v0[0], v0[1]); w.y = pk2(v0[2], v0[3]); w.z = pk2(v1[0], v1[1]); w.w = pk2(v1[2], v1[3]);
                        *(GAS u32x4*)(P + (size_t)row * LDP + pcol0 + bj * 128) = w;
                    }
                }
                asm volatile("" ::: "memory");
            }
    }
};
struct EpiRes {
    static constexpr bool PERM = false;
    const GAS float* xlat; const GAS float* xctx; GAS float* olat; GAS float* octx; const GAS float* gate;
    __device__ __forceinline__ void operator()(const f32x4 (&acc)[2][2][4][2], const pg8::Unit& u, int wr, int wc, int, int) const {
        const int lane = lane_id_v(), fr = lane & 15, fq = lane >> 4;
        const int row0 = u.pm * 256 + wr * 64 + fr, col0 = u.pn * 256 + wc * 32 + 4 * fq;
        const bool lat = u.pm < 256; const int mrow = lat ? (u.pm >> 3) : 32;
        f32x4 gv[2][2];
#pragma unroll
        for (int bj = 0; bj < 2; ++bj)
#pragma unroll
            for (int n = 0; n < 2; ++n) gv[bj][n] = *(const GAS f32x4*)(gate + (size_t)mrow * 3072 + col0 + bj * 128 + n * 16);
        f32x4 xs[2][2], xn[2][2];
        {
            const GAS float* src = lat ? xlat + (size_t)row0 * DM : xctx + (size_t)(row0 - NLAT) * DM;
#pragma unroll
            for (int bj = 0; bj < 2; ++bj)
#pragma unroll
                for (int n = 0; n < 2; ++n) xs[bj][n] = *(const GAS f32x4*)(src + col0 + bj * 128 + n * 16);
        }
#pragma unroll
        for (int it = 0; it < 8; ++it) {
            const int ai = it >> 2, m = it & 3;
            const int row = row0 + ai * 128 + m * 16;
            if (it < 7) {
                const int rown = row0 + ((it + 1) >> 2) * 128 + ((it + 1) & 3) * 16;
                const GAS float* srcn = lat ? xlat + (size_t)rown * DM : xctx + (size_t)(rown - NLAT) * DM;
#pragma unroll
                for (int bj = 0; bj < 2; ++bj)
#pragma unroll
                    for (int n = 0; n < 2; ++n) xn[bj][n] = *(const GAS f32x4*)(srcn + col0 + bj * 128 + n * 16);
            }
            GAS float* dst = lat ? olat + (size_t)row * DM : octx + (size_t)(row - NLAT) * DM;
#pragma unroll
            for (int bj = 0; bj < 2; ++bj)
#pragma unroll
                for (int n = 0; n < 2; ++n) *(GAS f32x4*)(dst + col0 + bj * 128 + n * 16) = xs[bj][n] + gv[bj][n] * acc[ai][bj][m][n];
#pragma unroll
            for (int bj = 0; bj < 2; ++bj)
#pragma unroll
                for (int n = 0; n < 2; ++n) xs[bj][n] = xn[bj][n];
            asm volatile("" ::: "memory");
        }
    }
};

__device__ __attribute__((noinline)) void small33(LAS unsigned char* lds, const GAS float* vecs, int vstride, const GAS float* vec32, bool act,
                                        const GAS float* W, int ldw, int ncols, int n0, const GAS float* bias, GAS float* out, int ldo, int tid) {
    LAS float* cs = (LAS float*)lds;
    LAS float* red = (LAS float*)(lds + 36864);
    const int col = tid & 63, ks = tid >> 6;
    float acc[33];
#pragma unroll
    for (int r = 0; r < 33; ++r) acc[r] = 0.f;
    const bool cok = (n0 + col) < ncols;
    for (int kc = 0; kc < 4; ++kc) {
        for (int idx = tid; idx < 33 * 256; idx += NTHREADS) {
            const int r = idx >> 8, kk = idx & 255;
            float v = (r < 32) ? vecs[(size_t)r * vstride + kc * 256 + kk] : vec32[kc * 256 + kk];
            if (act) v = v / (1.f + expf(-v));
            cs[kk * 36 + r] = v;
        }
        __syncthreads();
        for (int i = 0; i < 32; ++i) {
            const int kk = ks * 32 + i;
            const float w = cok ? W[(size_t)(kc * 256 + kk) * ldw + n0 + col] : 0.f;
#pragma unroll
            for (int r4 = 0; r4 < 8; ++r4) { const f32x4 c4 = *(const LAS f32x4*)(cs + kk * 36 + r4 * 4);
                acc[r4 * 4 + 0] += c4[0] * w; acc[r4 * 4 + 1] += c4[1] * w; acc[r4 * 4 + 2] += c4[2] * w; acc[r4 * 4 + 3] += c4[3] * w; }
            acc[32] += cs[kk * 36 + 32] * w;
        }
        __syncthreads();
    }
#pragma unroll
    for (int r = 0; r < 33; ++r) red[(ks * 33 + r) * 64 + col] = acc[r];
    __syncthreads();
    for (int idx = tid; idx < 33 * 64; idx += NTHREADS) {
        const int r = idx >> 6, c = idx & 63;
        float s = 0.f;
#pragma unroll
        for (int k = 0; k < 8; ++k) s += red[(k * 33 + r) * 64 + c];
        if (n0 + c < ncols) out[(size_t)r * ldo + n0 + c] = s + (bias ? bias[n0 + c] : 0.f);
    }
    __syncthreads();
}

__device__ __attribute__((noinline)) void tconv_tile(LAS unsigned char* lds, const GAS float* src, int lds_, GAS bf16_t* dst, int ldd, int k0, int n0, int tid) {
    LAS float* sm = (LAS float*)lds;
    { const int r = tid >> 4, c4 = (tid & 15) * 4;
#pragma unroll
      for (int ps = 0; ps < 2; ++ps) { const int row = r + 32 * ps; const f32x4 v = *(const GAS f32x4*)(src + (size_t)(k0 + row) * lds_ + n0 + c4);
          sm[row * 65 + c4 + 0] = v[0]; sm[row * 65 + c4 + 1] = v[1]; sm[row * 65 + c4 + 2] = v[2]; sm[row * 65 + c4 + 3] = v[3]; } }
    __syncthreads();
    { const int n = tid >> 3, k8 = (tid & 7) * 8; u32x4 w;
      w.x = pk2(sm[(k8 + 0) * 65 + n], sm[(k8 + 1) * 65 + n]); w.y = pk2(sm[(k8 + 2) * 65 + n], sm[(k8 + 3) * 65 + n]);
      w.z = pk2(sm[(k8 + 4) * 65 + n], sm[(k8 + 5) * 65 + n]); w.w = pk2(sm[(k8 + 6) * 65 + n], sm[(k8 + 7) * 65 + n]);
      *(GAS u32x4*)(dst + (size_t)(n0 + n) * ldd + k0 + k8) = w; }
    __syncthreads();
}

__device__ __attribute__((noinline)) void tconv_panel(LAS unsigned char* lds, const GAS float* src, int lds_, GAS bf16_t* dst, int ldd, int k0, int n0, int tid) {
    LAS float* sm = (LAS float*)lds;
    f32x4 v[8];
#pragma unroll
    for (int i = 0; i < 8; ++i) { const int idx = tid + NTHREADS * i, row = idx >> 6, c4 = (idx & 63) * 4; v[i] = *(const GAS f32x4*)(src + (size_t)(k0 + row) * lds_ + n0 + c4); }
#pragma unroll
    for (int i = 0; i < 8; ++i) { const int idx = tid + NTHREADS * i, row = idx >> 6, c4 = (idx & 63) * 4;
        sm[row * 257 + c4 + 0] = v[i][0]; sm[row * 257 + c4 + 1] = v[i][1]; sm[row * 257 + c4 + 2] = v[i][2]; sm[row * 257 + c4 + 3] = v[i][3]; }
    __syncthreads();
    { const int n = tid >> 1, kh = (tid & 1) * 32;
#pragma unroll
      for (int q = 0; q < 4; ++q) { const int k8 = kh + q * 8; u32x4 w;
          w.x = pk2(sm[(k8 + 0) * 257 + n], sm[(k8 + 1) * 257 + n]); w.y = pk2(sm[(k8 + 2) * 257 + n], sm[(k8 + 3) * 257 + n]);
          w.z = pk2(sm[(k8 + 4) * 257 + n], sm[(k8 + 5) * 257 + n]); w.w = pk2(sm[(k8 + 6) * 257 + n], sm[(k8 + 7) * 257 + n]);
          *(GAS u32x4*)(dst + (size_t)(n0 + n) * ldd + k0 + k8) = w; } }
    __syncthreads();
}

__device__ __attribute__((noinline)) void mod_mfma_task(GAS unsigned char* ws, const GAS float* c, const GAS float* c_ctx, const GAS float* w_ada, const GAS float* b_ada, int task, int tid) {
    const int lane = tid & 63, fr = lane & 15, fq = lane >> 4;
    const int l = task / 192, n0 = (task % 192) * 16;
    const GAS float* wl = w_ada + (size_t)l * 1024 * 3072 + n0 + fr + (size_t)(fq * 8) * 3072;
    const GAS float* a0p = c + (size_t)fr * 1024 + fq * 8;
    const GAS float* a1p = c + (size_t)(16 + fr) * 1024 + fq * 8;
    const GAS float* a2p = c_ctx + fq * 8;
    f32x4 acc0 = {0.f, 0.f, 0.f, 0.f}, acc1 = acc0, acc2 = acc0;
#pragma unroll 2
    for (int ks = 0; ks < 32; ++ks) {
        const GAS float* wp = wl + (size_t)(ks * 32) * 3072;
        f32x4 w0, w1;
#pragma unroll
        for (int e = 0; e < 4; ++e) { w0[e] = wp[(size_t)e * 3072]; w1[e] = wp[(size_t)(4 + e) * 3072]; }
        f32x4 x00 = *(const GAS f32x4*)(a0p + ks * 32), x01 = *(const GAS f32x4*)(a0p + ks * 32 + 4);
        f32x4 x10 = *(const GAS f32x4*)(a1p + ks * 32), x11 = *(const GAS f32x4*)(a1p + ks * 32 + 4);
        f32x4 x20 = *(const GAS f32x4*)(a2p + ks * 32), x21 = *(const GAS f32x4*)(a2p + ks * 32 + 4);
#pragma unroll
        for (int e = 0; e < 4; ++e) { x00[e] = silu_f(x00[e]); x01[e] = silu_f(x01[e]); x10[e] = silu_f(x10[e]); x11[e] = silu_f(x11[e]); x20[e] = silu_f(x20[e]); x21[e] = silu_f(x21[e]); }
        const bf16x8 b = pack8(w0, w1);
        acc0 = MFMA16(pack8(x00, x01), b, acc0); acc1 = MFMA16(pack8(x10, x11), b, acc1); acc2 = MFMA16(pack8(x20, x21), b, acc2);
    }
    const float bias = b_ada[l * 3072 + n0 + fr];
    GAS float* mo = (GAS float*)(ws + WS_MOD) + (size_t)l * 33 * 3072 + n0 + fr;
#pragma unroll
    for (int r = 0; r < 4; ++r) { mo[(size_t)(fq * 4 + r) * 3072] = acc0[r] + bias; mo[(size_t)(16 + fq * 4 + r) * 3072] = acc1[r] + bias; }
    if (fq == 0) mo[(size_t)32 * 3072] = acc2[0] + bias;
}

__device__ __attribute__((noinline)) void panel_tile(LAS unsigned char* lds, GAS unsigned char* ws, const GAS float* norm_w_l, int l, int tile, const GAS float* xlat, const GAS float* xctx, int tid) {
    LAS float* gvec = (LAS float*)lds;
    LAS unsigned char* wxl = lds + 4096;
    const int lane = tid & 63, w = tid >> 6, fr = lane & 15, fq = lane >> 4;
    const int rowb = tile * 128;
    const bool lat = rowb < NLAT;
    const int mrow = lat ? (rowb >> 11) : 32;
    const GAS float* modl = (const GAS float*)(ws + WS_MOD) + (size_t)l * 33 * 3072;
    for (int k = tid; k < 1024; k += NTHREADS) gvec[k] = norm_w_l[k] * (1.f + modl[(size_t)mrow * 3072 + 1024 + k]);
    { const GAS unsigned GAS char* wx = ws + WS_WX + (size_t)l * 32768;
#pragma unroll
      for (int i = 0; i < 4; ++i) { const int idx = tid + 512 * i, r = idx >> 7, cc = idx & 127; *(LAS u32x4*)(wxl + r * 2064 + cc * 16) = *(const GAS u32x4*)(wx + (size_t)idx * 16); } }
    __syncthreads();
    const int row = rowb + w * 16 + fr;
    const GAS float* xr = lat ? xlat + (size_t)row * DM : xctx + (size_t)(row - NLAT) * DM;
    GAS bf16_t* hr = (GAS bf16_t*)(ws + WS_H) + (size_t)row * DM;
    f32x4 acc = {0.f, 0.f, 0.f, 0.f}; float ss = 0.f;
    for (int kb = 0; kb < 4; ++kb) {
        f32x4 xa[4][4];
#pragma unroll
        for (int j4 = 0; j4 < 4; ++j4)
#pragma unroll
            for (int j = 0; j < 4; ++j) xa[j4][j] = *(const GAS f32x4*)(xr + (kb * 4 + j4) * 64 + j * 16 + fq * 4);
#pragma unroll
        for (int j4 = 0; j4 < 4; ++j4) {
            const int c0 = (kb * 4 + j4) * 64 + fq * 4;
            f32x4 xv[4];
#pragma unroll
            for (int j = 0; j < 4; ++j) { const f32x4 gvj = *(const LAS f32x4*)(gvec + c0 + j * 16); xv[j] = xa[j4][j];
                ss += xv[j][0] * xv[j][0] + xv[j][1] * xv[j][1] + xv[j][2] * xv[j][2] + xv[j][3] * xv[j][3]; xv[j] = xv[j] * gvj; }
            u32x4 lo, hi;
            lo.x = pk2(xv[0][0], xv[0][1]); lo.y = pk2(xv[0][2], xv[0][3]); lo.z = pk2(xv[1][0], xv[1][1]); lo.w = pk2(xv[1][2], xv[1][3]);
            hi.x = pk2(xv[2][0], xv[2][1]); hi.y = pk2(xv[2][2], xv[2][3]); hi.z = pk2(xv[3][0], xv[3][1]); hi.w = pk2(xv[3][2], xv[3][3]);
            *(GAS u32x2*)(hr + c0) = (u32x2){lo.x, lo.y}; *(GAS u32x2*)(hr + c0 + 16) = (u32x2){lo.z, lo.w};
            *(GAS u32x2*)(hr + c0 + 32) = (u32x2){hi.x, hi.y}; *(GAS u32x2*)(hr + c0 + 48) = (u32x2){hi.z, hi.w};
            const LAS unsigned char* wb = wxl + fr * 2064 + c0 * 2;
            const u32x2 b0 = *(const LAS u32x2*)(wb), b1 = *(const LAS u32x2*)(wb + 32), b2 = *(const LAS u32x2*)(wb + 64), b3 = *(const LAS u32x2*)(wb + 96);
            const bf16x8 blo = __builtin_bit_cast(bf16x8, (u32x4){b0.x, b0.y, b1.x, b1.y}), bhi = __builtin_bit_cast(bf16x8, (u32x4){b2.x, b2.y, b3.x, b3.y});
            acc = MFMA16(__builtin_bit_cast(bf16x8, lo), blo, acc); acc = MFMA16(__builtin_bit_cast(bf16x8, hi), bhi, acc);
        }
    }
    ss += __shfl_xor(ss, 16); ss += __shfl_xor(ss, 32);
    if (fq == 0) ((GAS float*)(ws + WS_RROW))[row] = rsqrtf(ss * (1.f / 1024.f) + 1e-6f);
    GAS float* px = (GAS float*)(ws + WS_PX);
#pragma unroll
    for (int r = 0; r < 4; ++r) px[(size_t)(rowb + w * 16 + fq * 4 + r) * 16 + fr] = acc[r];
    __syncthreads();
}

__device__ __attribute__((noinline)) void gmlp_tile(LAS unsigned char* lds, GAS unsigned char* ws, const GAS float* ln_w_l, const GAS float* a_bs_l, int l, int R0, int tid) {
    GAS bf16_t* P = (GAS bf16_t*)(ws + WS_P);
    LAS bf16_t* vcT = (LAS bf16_t*)lds;
    const int lane = tid & 63, w = tid >> 6, fr = lane & 15, fq = lane >> 4;
    {
        const int t = tid >> 2, gq = tid & 3;
        const GAS bf16_t* vp = P + (size_t)(R0 + t) * LDP + PA_V + gq * 8;
        float xv[64];
#pragma unroll
        for (int i = 0; i < 8; ++i) { const u32x4 q = *(const GAS u32x4*)(vp + i * 32);
            xv[i * 8 + 0] = bflo(q.x); xv[i * 8 + 1] = bfhi(q.x); xv[i * 8 + 2] = bflo(q.y); xv[i * 8 + 3] = bfhi(q.y);
            xv[i * 8 + 4] = bflo(q.z); xv[i * 8 + 5] = bfhi(q.z); xv[i * 8 + 6] = bflo(q.w); xv[i * 8 + 7] = bfhi(q.w); }
        float s = 0.f;
#pragma unroll
        for (int i = 0; i < 64; ++i) s += xv[i];
        s += __shfl_xor(s, 1); s += __shfl_xor(s, 2);
        const float mean = s * (1.f / 256.f);
        float q2 = 0.f;
#pragma unroll
        for (int i = 0; i < 64; ++i) { const float d = xv[i] - mean; q2 += d * d; }
        q2 += __shfl_xor(q2, 1); q2 += __shfl_xor(q2, 2);
        const float rs = rsqrtf(q2 * (1.f / 256.f) + 1e-5f);
#pragma unroll
        for (int i = 0; i < 64; ++i) { const int ch = ((i >> 3) * 4 + gq) * 8 + (i & 7); vcT[ch * 136 + t] = f2bf((xv[i] - mean) * rs * ln_w_l[ch]); }
    }
    __syncthreads();
    const int g = w >> 1, ih = w & 1;
    f32x4 acc[4][4];
#pragma unroll
    for (int mi = 0; mi < 4; ++mi)
#pragma unroll
        for (int ni = 0; ni < 4; ++ni) acc[mi][ni] = (f32x4){0.f, 0.f, 0.f, 0.f};
    const GAS bf16_t* aw = (const GAS bf16_t*)(ws + WS_AWS) + (size_t)(l * 4 + g) * 128 * 128;
#pragma unroll
    for (int ks = 0; ks < 4; ++ks) {
        bf16x8 af[4], bf[4];
#pragma unroll
        for (int mi = 0; mi < 4; ++mi) af[mi] = *(const GAS bf16x8*)(aw + (size_t)(ih * 64 + mi * 16 + fr) * 128 + ks * 32 + fq * 8);
#pragma unroll
        for (int ni = 0; ni < 4; ++ni) bf[ni] = *(const LAS bf16x8*)(vcT + (g * 64 + (ni >> 1) * 32 + (fr >> 2) * 8 + (ni & 1) * 4 + (fr & 3)) * 136 + ks * 32 + fq * 8);
#pragma unroll
        for (int mi = 0; mi < 4; ++mi)
#pragma unroll
            for (int ni = 0; ni < 4; ++ni) acc[mi][ni] = MFMA16(bf[ni], af[mi], acc[mi][ni]);
    }
#pragma unroll
    for (int mi = 0; mi < 4; ++mi) {
        const int tok = ih * 64 + mi * 16 + fr;
        const float bs = a_bs_l[g * 128 + tok];
        GAS bf16_t* pr = P + (size_t)(R0 + tok) * LDP;
#pragma unroll
        for (int a2 = 0; a2 < 2; ++a2) {
            const int c0 = g * 64 + a2 * 32 + fq * 8;
            const u32x4 uu = *(const GAS u32x4*)(pr + PA_U + c0), zz = *(const GAS u32x4*)(pr + PA_Z + c0);
            const f32x4 s0 = acc[mi][2 * a2], s1 = acc[mi][2 * a2 + 1];
            u32x4 o;
            o.x = pk2(bflo(uu.x) * (s0[0] + bs) * silu_f(bflo(zz.x)), bfhi(uu.x) * (s0[1] + bs) * silu_f(bfhi(zz.x)));
            o.y = pk2(bflo(uu.y) * (s0[2] + bs) * silu_f(bflo(zz.y)), bfhi(uu.y) * (s0[3] + bs) * silu_f(bfhi(zz.y)));
            o.z = pk2(bflo(uu.z) * (s1[0] + bs) * silu_f(bflo(zz.z)), bfhi(uu.z) * (s1[1] + bs) * silu_f(bfhi(zz.z)));
            o.w = pk2(bflo(uu.w) * (s1[2] + bs) * silu_f(bflo(zz.w)), bfhi(uu.w) * (s1[3] + bs) * silu_f(bfhi(zz.w)));
            *(GAS u32x4*)(pr + PA_U + c0) = o;
        }
    }
    __syncthreads();
}

__device__ __forceinline__ void attn_tile(LAS unsigned char* lds, GAS unsigned char* ws, const GAS float* sw, int b, int h, int qrow0, int nkt, float lam, float osc, int w) {
    GAS bf16_t* P = (GAS bf16_t*)(ws + WS_P);
    const GAS bf16_t* VT = (const GAS bf16_t*)(ws + WS_VT);
    const int lane = lane_id_v(), tid = w * 64 + lane, sub = w >> 2, qw = w & 3, l31 = lane & 31, hi = lane >> 5;
    const int qrow = qrow0 + qw * 32 + l31;
    bf16x8 qf[4];
    { const GAS bf16_t* qp = P + (size_t)qrow * LDP + PB_Q + (2 * h + sub) * 64 + hi * 8;
#pragma unroll
      for (int ks = 0; ks < 4; ++ks) qf[ks] = *(const GAS bf16x8*)(qp + ks * 16); }
    f32x16 O[4];
    float zf; asm volatile("v_mov_b32 %0, 0" : "=v"(zf));
#pragma unroll
    for (int d = 0; d < 4; ++d)
#pragma unroll
        for (int r = 0; r < 16; ++r) O[d][r] = zf;
    float m = -INFINITY, lsum = 0.f;
    const float cs = 0.125f * 1.44269504088896f;
    u32x4 kr[2][2], vr[2][2];
    const GAS bf16_t* vbase = VT + (size_t)(b * 4 + h) * 128 * 2304;
#define ATT_LOAD(kt, S_) do { const int krow0_ = ((kt) < 4) ? (NLAT + b * 256 + (kt) * 64) : (b * 2048 + ((kt) - 4) * 64); \
        _Pragma("unroll") for (int i_ = 0; i_ < 2; ++i_) { const int idx_ = tid + 512 * i_; \
            kr[S_][i_] = *(const GAS u32x4*)(P + (size_t)(krow0_ + (idx_ >> 4)) * LDP + PB_K + 2 * h * 64 + (idx_ & 15) * 8); \
            vr[S_][i_] = *(const GAS u32x4*)(vbase + (size_t)(idx_ >> 3) * 2304 + (kt) * 64 + (idx_ & 7) * 8); } } while (0)
#define ATT_STORE(s, S_) do { _Pragma("unroll") for (int i_ = 0; i_ < 2; ++i_) { const int idx_ = tid + 512 * i_; const int key_ = idx_ >> 4, part_ = idx_ & 15; \
            *(LAS u32x4*)(lds + (s) * 36864 + (((part_ >> 3) * 64 + key_) * 72 + (part_ & 7) * 8) * 2) = kr[S_][i_]; \
            *(LAS u32x4*)(lds + (s) * 36864 + 18432 + ((idx_ >> 3) * 72 + (idx_ & 7) * 8) * 2) = vr[S_][i_]; } } while (0)
#define KFR(rowo, ks_) (*(const LAS bf16x8*)(kb_ + (((rowo) + l31) * 72 + (ks_) * 16 + hi * 8) * 2))
#define VFR(d_, g_) (*(const LAS bf16x8*)(vb_ + (((d_) * 32 + l31) * 72 + (g_) * 16 + hi * 8) * 2))
#define ATT_BODY(KT_, LSET_, SSET_) do { const int s = (KT_) & 1; \
        if ((KT_) + 2 < nkt) ATT_LOAD((KT_) + 2, LSET_); \
        f32x16 S0, S1; \
        const LAS unsigned char* kb_ = lds + s * 36864 + sub * (64 * 72 * 2); \
        const LAS unsigned char* vb_ = lds + s * 36864 + 18432; \
        bf16x8 a0 = KFR(0, 0), a1 = KFR(32, 0); \
_Pragma("unroll") \
        for (int ks = 0; ks < 4; ++ks) { \
            bf16x8 n0 = a0, n1 = a1; \
            if (ks < 3) { n0 = KFR(0, ks + 1); n1 = KFR(32, ks + 1); } \
            __builtin_amdgcn_sched_barrier(0); \
            if (ks == 0) { const f32x16 z = {0.f, 0.f, 0.f, 0.f, 0.f, 0.f, 0.f, 0.f, 0.f, 0.f, 0.f, 0.f, 0.f, 0.f, 0.f, 0.f}; S0 = MFMA32(a0, qf[0], z); S1 = MFMA32(a1, qf[0], z); } \
            else { S0 = MFMA32(a0, qf[ks], S0); S1 = MFMA32(a1, qf[ks], S1); } \
            __builtin_amdgcn_sched_barrier(0); \
            a0 = n0; a1 = n1; \
        } \
        bf16x8 vfr[4];    \
_Pragma("unroll") \
        for (int d = 0; d < 4; ++d) vfr[d] = VFR(d, 0); \
        __builtin_amdgcn_sched_barrier(0); \
        float mx = S0[0]; \
_Pragma("unroll") \
        for (int r = 1; r < 16; ++r) mx = fmaxf(mx, S0[r]); \
_Pragma("unroll") \
        for (int r = 0; r < 16; ++r) mx = fmaxf(mx, S1[r]); \
        mx = fmaxf(mx, shfl_x32(mx, lane)); \
        if (__builtin_amdgcn_ballot_w64((mx - m) * cs > 8.f) != 0ull) { \
            const float mn = fmaxf(m, mx); \
            const float alpha = __builtin_amdgcn_exp2f((m - mn) * cs); \
            m = mn; \
            lsum *= alpha; \
_Pragma("unroll") \
            for (int d = 0; d < 4; ++d) \
_Pragma("unroll") \
                for (int r = 0; r < 16; ++r) O[d][r] *= alpha; \
        } \
        const float mc = m * cs; \
        float rs = 0.f; \
        bf16x8 pk[2][2]; \
_Pragma("unroll") \
        for (int s2 = 0; s2 < 2; ++s2) { \
            u32x4 t0, t1; \
_Pragma("unroll") \
            for (int j = 0; j < 4; ++j) { \
                const float e0 = __builtin_amdgcn_exp2f(S0[8 * s2 + 2 * j] * cs - mc), e1 = __builtin_amdgcn_exp2f(S0[8 * s2 + 2 * j + 1] * cs - mc); \
                const float f0 = __builtin_amdgcn_exp2f(S1[8 * s2 + 2 * j] * cs - mc), f1 = __builtin_amdgcn_exp2f(S1[8 * s2 + 2 * j + 1] * cs - mc); \
                rs += (e0 + e1) + (f0 + f1); \
                t0[j] = pk2(e0, e1); t1[j] = pk2(f0, f1); \
            } \
            pk[0][s2] = __builtin_bit_cast(bf16x8, t0); pk[1][s2] = __builtin_bit_cast(bf16x8, t1); \
        } \
        lsum += rs; \
        __builtin_amdgcn_sched_barrier(0); \
_Pragma("unroll") \
        for (int g = 0; g < 4; ++g) {    \
            bf16x8 nfr[4]; \
_Pragma("unroll") \
            for (int d = 0; d < 4; ++d) nfr[d] = (g < 3) ? VFR(d, g + 1) : vfr[d]; \
            __builtin_amdgcn_sched_barrier(0); \
_Pragma("unroll") \
            for (int d = 0; d < 4; ++d) O[d] = MFMA32(vfr[d], pk[g >> 1][g & 1], O[d]); \
            __builtin_amdgcn_sched_barrier(0); \
_Pragma("unroll") \
            for (int d = 0; d < 4; ++d) vfr[d] = nfr[d]; \
        } \
        if ((KT_) + 1 < nkt) ATT_STORE(s ^ 1, SSET_); \
        __syncthreads(); } while (0)
    ATT_LOAD(0, 0); ATT_STORE(0, 0);
    if (nkt > 1) ATT_LOAD(1, 1);
    __syncthreads();
    if (sub == 1) __builtin_amdgcn_s_setprio(1);
    for (int kt = 0; kt < nkt; kt += 2) {
        ATT_BODY(kt, 0, 1);
        ATT_BODY(kt + 1, 1, 0);
    }
#undef ATT_BODY
    __builtin_amdgcn_s_setprio(0);
#undef KFR
#undef VFR
#undef ATT_LOAD
#undef ATT_STORE
    lsum += shfl_x32(lsum, lane);
    const float inv = 1.f / lsum;
    LAS float* O2 = (LAS float*)lds;
    if (sub == 1) {
#pragma unroll
        for (int d = 0; d < 4; ++d)
#pragma unroll
            for (int rg = 0; rg < 4; ++rg) { f32x4 v = {O[d][4 * rg] * inv, O[d][4 * rg + 1] * inv, O[d][4 * rg + 2] * inv, O[d][4 * rg + 3] * inv};
                *(LAS f32x4*)(O2 + (qw * 32 + l31) * 132 + d * 32 + 8 * rg + 4 * hi) = v; }
    }
    __syncthreads();
    if (sub == 0) {
        float ss = 0.f;
#pragma unroll
        for (int d = 0; d < 4; ++d)
#pragma unroll
            for (int rg = 0; rg < 4; ++rg) { const f32x4 o2 = *(const LAS f32x4*)(O2 + (qw * 32 + l31) * 132 + d * 32 + 8 * rg + 4 * hi);
#pragma unroll
                for (int e = 0; e < 4; ++e) { const float o = O[d][4 * rg + e] * inv - lam * o2[e]; O[d][4 * rg + e] = o; ss += o * o; } }
        ss += shfl_x32(ss, lane);
        const float rr = rsqrtf(ss * (1.f / 128.f) + 1e-6f) * osc;
        GAS bf16_t* zp0 = P + (size_t)qrow * LDP + PB_Z + h * 128;
#pragma unroll
        for (int d = 0; d < 4; ++d)
#pragma unroll
            for (int rg = 0; rg < 4; ++rg) { const int dv0 = d * 32 + 8 * rg + 4 * hi;
                const f32x4 w4 = *(const GAS f32x4*)(sw + dv0); const u32x2 zz = *(const GAS u32x2*)(zp0 + dv0);
                const float y0 = O[d][4 * rg + 0] * rr * w4[0] * silu_f(bflo(zz.x)), y1 = O[d][4 * rg + 1] * rr * w4[1] * silu_f(bfhi(zz.x));
                const float y2 = O[d][4 * rg + 2] * rr * w4[2] * silu_f(bflo(zz.y)), y3 = O[d][4 * rg + 3] * rr * w4[3] * silu_f(bfhi(zz.y));
                u32x2 o; o.x = pk2(y0, y1); o.y = pk2(y2, y3); *(GAS u32x2*)(zp0 + dv0) = o; }
    }
    __syncthreads();
}

template <int DD>
__device__ __forceinline__ void gdn_solve(const LAS float* Lb, const LAS float* src, const LAS float* fac, int lane, int part, GAS unsigned char* rec) {
    float x[64];
#pragma unroll
    for (int p = 0; p < 64; ++p) {
        const int tn = DD ? 63 - p : p;
        const float rhs = src[tn * 68 + lane] * fac[p];
        f32x2 sa = {0.f, 0.f}, sb = {0.f, 0.f};
#pragma unroll
        for (int q = 0; q < p; q += 4) {
            f32x4 lv;
            if (DD == 0) lv = *(const LAS f32x4*)(Lb + p * 68 + q);
            else { const f32x4 t = *(const LAS f32x4*)(Lb + (63 - p) * 68 + (60 - q)); lv = (f32x4){t[3], t[2], t[1], t[0]}; }
            if (q + 1 < p) sa += (f32x2){lv[0], lv[1]} * (f32x2){x[q], x[q + 1]}; else sa[0] += lv[0] * x[q];
            if (q + 3 < p) sb += (f32x2){lv[2], lv[3]} * (f32x2){x[q + 2], x[q + 3]}; else if (q + 2 < p) sb[0] += lv[2] * x[q + 2];
        }
        x[p] = rhs - ((sa[0] + sa[1]) + (sb[0] + sb[1]));
    }
    if (part == 0) {
        GAS bf16_t* ut = (GAS bf16_t*)(rec + 32768) + lane * 64;
#pragma unroll
        for (int i = 0; i < 8; ++i) { u32x4 w; w.x = pk2(x[8 * i], x[8 * i + 1]); w.y = pk2(x[8 * i + 2], x[8 * i + 3]); w.z = pk2(x[8 * i + 4], x[8 * i + 5]); w.w = pk2(x[8 * i + 6], x[8 * i + 7]); *(GAS u32x4*)(ut + 8 * i) = w; }
    } else {
        GAS bf16_t* wn = (GAS bf16_t*)rec + pi64(lane);
#pragma unroll
        for (int p = 0; p < 64; ++p) wn[p * 64] = f2bf(-x[p]);
    }
}

__device__ __attribute__((noinline)) void gdn_prep_tile(LAS unsigned char* lds, GAS unsigned char* ws, const GAS float* conv_w_l, const GAS float* a_log_l, const GAS float* dt_bias_l, int l, int b, int seg, int c, int hp, int tid) {
    const GAS bf16_t* P = (const GAS bf16_t*)(ws + WS_P);
    const int hh = tid >> 8, ltid = tid & 255, lane = tid & 63, wv = (tid >> 6) & 3, fr = lane & 15, fq = lane >> 4;
    const int h = hp * 2 + hh;
    LAS unsigned char* hb = lds + hh * 71680;
    LAS float* qf = (LAS float*)hb; LAS float* kf = (LAS float*)(hb + 17408); LAS float* vf = (LAS float*)(hb + 34816); LAS float* Lb = (LAS float*)(hb + 52224);
    LAS float* beta = (LAS float*)(hb + 69632); LAS float* gg = (LAS float*)(hb + 70144); LAS float* gc = (LAS float*)(hb + 70656); LAS float* fw = (LAS float*)(hb + 71168);
    const int seglen = seg ? SEQL : CTXL;
    const int rowbase = seg ? b * SEQL : NLAT + b * CTXL;
    const int mrow = seg ? b : 32;
    {
        const int ch2 = ltid & 31, tg = ltid >> 5;
#pragma unroll
        for (int part = 0; part < 3; ++part) {
            const int col = PC_Q + part * 256 + h * 64 + 2 * ch2;
            const GAS float* cw = conv_w_l + part * 256 + h * 64 + 2 * ch2;
            float w0[5], w1[5];
#pragma unroll
            for (int j = 0; j < 5; ++j) { const f32x2 t = *(const GAS f32x2*)(cw + j * 768); w0[j] = t[0]; w1[j] = t[1]; }
            float x0[12], x1[12];
#pragma unroll
            for (int i = 0; i < 12; ++i) { const int tt = c * 64 + tg * 8 - 2 + i;
                unsigned u = 0u; if (tt >= 0 && tt < seglen) u = *(const GAS unsigned*)(P + (size_t)(rowbase + tt) * LDP + col);
                x0[i] = bflo(u); x1[i] = bfhi(u); }
            LAS float* dst = part == 0 ? qf : (part == 1 ? kf : vf);
#pragma unroll
            for (int o = 0; o < 8; ++o) { float s0 = 0.f, s1 = 0.f;
#pragma unroll
                for (int j = 0; j < 5; ++j) { s0 += x0[o + j] * w0[j]; s1 += x1[o + j] * w1[j]; }
                *(LAS f32x2*)(dst + (tg * 8 + o) * 68 + 2 * ch2) = (f32x2){silu_f(s0), silu_f(s1)}; }
        }
    }
    __syncthreads();
    {
        const int rr = ltid >> 1, half = ltid & 1;
        LAS float* rp = (rr < 64 ? qf + rr * 68 : kf + (rr - 64) * 68) + half * 32;
        float v[32]; float ss = 0.f;
#pragma unroll
        for (int i = 0; i < 8; ++i) { const f32x4 t = *(const LAS f32x4*)(rp + 4 * i); v[4 * i] = t[0]; v[4 * i + 1] = t[1]; v[4 * i + 2] = t[2]; v[4 * i + 3] = t[3]; ss += t[0] * t[0] + t[1] * t[1] + t[2] * t[2] + t[3] * t[3]; }
        ss += __shfl_xor(ss, 1);
        const float sc = rsqrtf(ss + 1e-6f);
#pragma unroll
        for (int i = 0; i < 8; ++i) *(LAS f32x4*)(rp + 4 * i) = (f32x4){v[4 * i] * sc, v[4 * i + 1] * sc, v[4 * i + 2] * sc, v[4 * i + 3] * sc};
        if (ltid < 128) {
            const int dd = ltid >> 6, p = ltid & 63, tn = dd ? 63 - p : p;
            const int row = rowbase + c * 64 + tn;
            const float rw = ((const GAS float*)(ws + WS_RROW))[row];
            const GAS float* px = (const GAS float*)(ws + WS_PX) + (size_t)row * 16;
            const GAS float* sw = (const GAS float*)(ws + WS_SW) + (size_t)l * 33 * DIN + (size_t)mrow * DIN + 3840;
            const float braw = px[dd * 4 + h] * rw + sw[dd * 4 + h];
            const float araw = px[8 + dd * 4 + h] * rw + sw[8 + dd * 4 + h];
            const float xs = araw + dt_bias_l[dd * 4 + h];
            const float sp = xs > 20.f ? xs : log1pf(expf(xs));
            beta[dd * 64 + p] = 1.f / (1.f + expf(-braw));
            gg[dd * 64 + p] = -expf(a_log_l[dd * 4 + h]) * sp;
        }
    }
    __syncthreads();
    if (wv == 0) {
#pragma unroll
        for (int dd = 0; dd < 2; ++dd) {
            float v = gg[dd * 64 + lane];
#pragma unroll
            for (int o = 1; o < 64; o <<= 1) { const float t = __shfl_up(v, o); if (lane >= o) v += t; }
            gc[dd * 64 + lane] = v;
            fw[dd * 64 + lane] = beta[dd * 64 + lane] * fexp(v);
            gg[dd * 64 + lane] = fexp(__shfl(v, 63) - v);
        }
    }
    __syncthreads();
    const int st0 = seg ? 4 + c : c, st1 = seg ? 4 + (31 - c) : 3 - c;
    GAS unsigned char* rec0 = ws + WS_H + ((size_t)((b * 4 + h) * 2 + 0) * 36 + st0) * GREC;
    GAS unsigned char* rec1 = ws + WS_H + ((size_t)((b * 4 + h) * 2 + 1) * 36 + st1) * GREC;
    {
        const int mt = wv;
        bf16x8 ak[2], aq[2];
#pragma unroll
        for (int ks = 0; ks < 2; ++ks) {
            const LAS float* kp = kf + (mt * 16 + fr) * 68 + ks * 32 + fq * 8; const LAS float* qp = qf + (mt * 16 + fr) * 68 + ks * 32 + fq * 8;
            ak[ks] = pack8(*(const LAS f32x4*)kp, *(const LAS f32x4*)(kp + 4)); aq[ks] = pack8(*(const LAS f32x4*)qp, *(const LAS f32x4*)(qp + 4));
        }
#pragma unroll
        for (int nt = 0; nt < 4; ++nt) {
            bf16x8 bk[2];
#pragma unroll
            for (int ks = 0; ks < 2; ++ks) { const LAS float* kp = kf + (nt * 16 + fr) * 68 + ks * 32 + fq * 8; bk[ks] = pack8(*(const LAS f32x4*)kp, *(const LAS f32x4*)(kp + 4)); }
            f32x4 KK = {0.f, 0.f, 0.f, 0.f}, QK = {0.f, 0.f, 0.f, 0.f};
            KK = MFMA16(ak[0], bk[0], KK); KK = MFMA16(ak[1], bk[1], KK);
            QK = MFMA16(aq[0], bk[0], QK); QK = MFMA16(aq[1], bk[1], QK);
            const int j = nt * 16 + fr;
            const float g0j = gc[j], g1j = gc[64 + 63 - j];
#pragma unroll
            for (int r = 0; r < 4; ++r) {
                const int i = mt * 16 + fq * 4 + r;
                const float g0i = gc[i], g1i = gc[64 + 63 - i];
                if (i > j) Lb[i * 68 + j] = beta[i] * KK[r] * fexp(g0i - g0j);
                else if (i < j) Lb[i * 68 + j] = beta[64 + 63 - i] * KK[r] * fexp(g1i - g1j);
                const float qv = QK[r] * 0.125f;
                const float a0 = (i >= j) ? qv * fexp(g0i - g0j) : 0.f;
                const float a1 = (i <= j) ? qv * fexp(g1i - g1j) : 0.f;
                ((GAS bf16_t*)(rec0 + 16384))[i * 64 + pi64(j)] = f2bf(a0);
                ((GAS bf16_t*)(rec1 + 16384))[(63 - i) * 64 + pi64(63 - j)] = f2bf(a1);
            }
        }
#pragma unroll
        for (int it = 0; it < 4; ++it) {
            const int idx = ltid + 256 * it, dd = idx >> 9, rem = idx & 511, rowi = rem >> 3, blk = rem & 7, ks = blk >> 2, q4 = blk & 3;
            GAS unsigned char* rec = dd ? rec1 : rec0;
            {
                const int tn = dd ? 63 - rowi : rowi; const float f = 0.125f * fexp(gc[dd * 64 + rowi]);
                const f32x4 v0 = *(const LAS f32x4*)(qf + tn * 68 + 32 * ks + 4 * q4), v1 = *(const LAS f32x4*)(qf + tn * 68 + 32 * ks + 16 + 4 * q4);
                *(GAS bf16x8*)((GAS bf16_t*)(rec + 8192) + rowi * 64 + blk * 8) = pack8(v0 * f, v1 * f);
            }
            {
                const f32x4 ek0 = *(const LAS f32x4*)(gg + dd * 64 + 32 * ks + 4 * q4), ek1 = *(const LAS f32x4*)(gg + dd * 64 + 32 * ks + 16 + 4 * q4);
                f32x4 v0, v1;
#pragma unroll
                for (int e = 0; e < 4; ++e) { const int p0 = 32 * ks + 4 * q4 + e, p1 = p0 + 16; const int t0 = dd ? 63 - p0 : p0, t1 = dd ? 63 - p1 : p1;
                    v0[e] = kf[t0 * 68 + rowi] * ek0[e]; v1[e] = kf[t1 * 68 + rowi] * ek1[e]; }
                *(GAS bf16x8*)((GAS bf16_t*)(rec + 24576) + rowi * 64 + blk * 8) = pack8(v0, v1);
            }
        }
        if (ltid < 2) { const int dd = ltid; ((GAS float*)(ws + WS_EG))[((b * 4 + h) * 2 + dd) * 36 + (dd ? st1 : st0)] = fexp(gc[dd * 64 + 63]); }
    }
    __syncthreads();
    {
        const int dd = wv >> 1, part = wv & 1;
        const LAS float* src = part ? kf : vf;
        const LAS float* fac = part ? fw + dd * 64 : beta + dd * 64;
        if (dd == 0) gdn_solve<0>(Lb, src, fac, lane, part, rec0); else gdn_solve<1>(Lb, src, fac, lane, part, rec1);
    }
    __syncthreads();
}

__device__ __attribute__((noinline)) void gdn_scan_tile(LAS unsigned char* lds, GAS unsigned char* ws, int t, int tid) {
    GAS bf16_t* P = (GAS bf16_t*)(ws + WS_P);
    const int lane = tid & 63, w = tid >> 6, sq = w >> 2, sl = w & 3, fr = lane & 15, fq = lane >> 4, lt = tid & 255;
    const int sid = 2 * t + sq, dd = sid & 1, h = (sid >> 1) & 3, b = sid >> 3;
    const GAS unsigned GAS char* rec0 = ws + WS_H + (size_t)sid * 36 * GREC;
    const GAS float* EG = (const GAS float*)(ws + WS_EG) + sid * 36;
    f32x4 S[4];
#pragma unroll
    for (int i = 0; i < 4; ++i) S[i] = (f32x4){0.f, 0.f, 0.f, 0.f};
    u32x4 pre[8]; u32x2 ut[4], utn[4]; float eg, egn;
#define SC_LOAD(st) do { const GAS unsigned GAS char* rec_ = rec0 + (size_t)(st) * GREC; \
        _Pragma("unroll") for (int i_ = 0; i_ < 8; ++i_) pre[i_] = *(const GAS u32x4*)(rec_ + (size_t)(lt + 256 * i_) * 16); \
        _Pragma("unroll") for (int m_ = 0; m_ < 4; ++m_) utn[m_] = *(const GAS u32x2*)(rec_ + 32768 + ((sl * 16 + fr) * 64 + m_ * 16 + fq * 4) * 2); \
        egn = EG[(st)]; } while (0)
#define SC_STORE(pp) do { _Pragma("unroll") for (int i_ = 0; i_ < 8; ++i_) { const int idx_ = lt + 256 * i_; \
        *(LAS u32x4*)(lds + ((pp) * 2 + sq) * 36864 + (idx_ >> 9) * 9216 + ((idx_ >> 3) & 63) * 144 + (idx_ & 7) * 16) = pre[i_]; } \
        _Pragma("unroll") for (int m_ = 0; m_ < 4; ++m_) ut[m_] = utn[m_]; eg = egn; } while (0)
    SC_LOAD(0); SC_STORE(0); __syncthreads();
    for (int st = 0; st < 36; ++st) {
        if (st + 1 < 36) SC_LOAD(st + 1);
        const LAS unsigned char* B = lds + ((st & 1) * 2 + sq) * 36864;
#define SC_FR(arr, mt, ks) (*(const LAS bf16x8*)(B + (arr) * 9216 + ((mt) * 16 + fr) * 144 + ((ks) * 32 + fq * 8) * 2))
        bf16x8 Sb[2], Vb[2];
        Sb[0] = pack8(S[0], S[1]); Sb[1] = pack8(S[2], S[3]);
        f32x4 av[4], ao[4];
#pragma unroll
        for (int mt = 0; mt < 4; ++mt) { av[mt] = (f32x4){bflo(ut[mt].x), bfhi(ut[mt].x), bflo(ut[mt].y), bfhi(ut[mt].y)};
            av[mt] = MFMA16(SC_FR(0, mt, 0), Sb[0], av[mt]); av[mt] = MFMA16(SC_FR(0, mt, 1), Sb[1], av[mt]); }
        Vb[0] = pack8(av[0], av[1]); Vb[1] = pack8(av[2], av[3]);
#pragma unroll
        for (int mt = 0; mt < 4; ++mt) { ao[mt] = (f32x4){0.f, 0.f, 0.f, 0.f};
            ao[mt] = MFMA16(SC_FR(1, mt, 0), Sb[0], ao[mt]); ao[mt] = MFMA16(SC_FR(1, mt, 1), Sb[1], ao[mt]);
            ao[mt] = MFMA16(SC_FR(2, mt, 0), Vb[0], ao[mt]); ao[mt] = MFMA16(SC_FR(2, mt, 1), Vb[1], ao[mt]); }
#pragma unroll
        for (int mt = 0; mt < 4; ++mt) { f32x4 as = S[mt] * eg;
            as = MFMA16(SC_FR(3, mt, 0), Vb[0], as); as = MFMA16(SC_FR(3, mt, 1), Vb[1], as); S[mt] = as; }
#undef SC_FR
        {
            const int seg = st >= 4, ci = seg ? st - 4 : st;
            const int cn = dd ? (seg ? 31 - ci : 3 - ci) : ci;
            const int rowbase = (seg ? b * SEQL : NLAT + b * CTXL) + cn * 64;
            GAS bf16_t* op = P + (dd ? PC_K : PC_Q) + h * 64 + sl * 16 + fr;
#pragma unroll
            for (int mt = 0; mt < 4; ++mt)
#pragma unroll
                for (int r = 0; r < 4; ++r) { const int p = mt * 16 + fq * 4 + r, tn = dd ? 63 - p : p; op[(size_t)(rowbase + tn) * LDP] = f2bf(ao[mt][r]); }
        }
        if (st + 1 < 36) SC_STORE((st + 1) & 1);
        __syncthreads();
    }
#undef SC_LOAD
#undef SC_STORE
}


__device__ __forceinline__ void gemm_in_phase(LAS unsigned char* lds, GAS unsigned char* ws, int l, int G, int bx, int wid) {
    GAS float* sWl = (GAS float*)(ws + WS_SW) + (size_t)l * 33 * DIN;
    pg8::Gemm g{(const GAS bf16_t*)(ws + WS_H), (const GAS bf16_t*)(ws + WS_WIN) + (size_t)l * 3840 * 1024, NT, NPJ, 1024, 1024, 0};
    pg8::StaticOrder S; if (l == 1) { S.init(NLAT, NPJ, G, bx); S.nextra = 32 * 7; } else S.init(NT, NPJ, G, bx);
    EpiP E{(GAS bf16_t*)(ws + WS_P), (GAS bf16_t*)(ws + WS_VT), (const GAS float*)(ws + WS_RROW), sWl, (const GAS f32x2*)(ws + WS_ROPE)};
    pg8::gemm_phase<EpiP>(lds, g, S, E, wid);
}
__device__ __forceinline__ void gemm_out_phase(LAS unsigned char* lds, GAS unsigned char* ws, int l, int G, int bx, const GAS float* xlat, const GAS float* xctx, GAS float* out, int wid) {
    const GAS float* modl = (const GAS float*)(ws + WS_MOD) + (size_t)l * 33 * 3072;
    const int M = l ? NLAT : NT;
    pg8::Gemm g{(const GAS bf16_t*)(ws + WS_P), (const GAS bf16_t*)(ws + WS_WOUT) + (size_t)l * 1024 * 1024, M, 1024, 1024, LDP, 1};
    pg8::StaticOrder S; S.init(M, 1024, G, bx);
    EpiRes E{xlat, xctx, out, (GAS float*)(ws + WS_XC1), modl + 2048};
    pg8::gemm_phase<EpiRes>(lds, g, S, E, wid);
}


__device__ __attribute__((noinline)) float compute_lam(const GAS float* lf, float lam_init, int tid) {
    const int ln = tid & 63;
    float p1 = lf[ln] * lf[64 + ln], p2 = lf[128 + ln] * lf[192 + ln];
#pragma unroll
    for (int o = 32; o >= 1; o >>= 1) { p1 += __shfl_xor(p1, o); p2 += __shfl_xor(p2, o); }
    return expf(p1) - expf(p2) + lam_init;
}
__device__ __attribute__((noinline)) void gdn_finish_phase(GAS unsigned char* ws, const GAS float* cw, int nrows, int vb, int G, int tid) {
    GAS bf16_t* P = (GAS bf16_t*)(ws + WS_P);
    const size_t total = (size_t)nrows * 32, stride = (size_t)G * NTHREADS;
    for (size_t idx0 = (size_t)vb * NTHREADS + tid; idx0 < total; idx0 += 3 * stride) {
        u32x4 of[3], ob[3], zz[3];
#pragma unroll
        for (int q = 0; q < 3; ++q) { const size_t idx = idx0 + q * stride;
            if (idx < total) { const int row = (int)(idx >> 5), hg = (int)(idx & 31);
                const GAS bf16_t* pr = P + (size_t)row * LDP + hg * 8;
                of[q] = *(const GAS u32x4*)(pr + PC_Q); ob[q] = *(const GAS u32x4*)(pr + PC_K); zz[q] = *(const GAS u32x4*)(pr + PC_Z); } }
#pragma unroll
        for (int q = 0; q < 3; ++q) { const size_t idx = idx0 + q * stride;
            if (idx < total) { const int row = (int)(idx >> 5), hg = (int)(idx & 31), part = hg & 7;
                GAS bf16_t* pr = P + (size_t)row * LDP + hg * 8;
                float o[8];
                o[0] = bflo(of[q].x) + bflo(ob[q].x); o[1] = bfhi(of[q].x) + bfhi(ob[q].x); o[2] = bflo(of[q].y) + bflo(ob[q].y); o[3] = bfhi(of[q].y) + bfhi(ob[q].y);
                o[4] = bflo(of[q].z) + bflo(ob[q].z); o[5] = bfhi(of[q].z) + bfhi(ob[q].z); o[6] = bflo(of[q].w) + bflo(ob[q].w); o[7] = bfhi(of[q].w) + bfhi(ob[q].w);
                float ss = 0.f;
#pragma unroll
                for (int e = 0; e < 8; ++e) ss += o[e] * o[e];
                ss += __shfl_xor(ss, 1); ss += __shfl_xor(ss, 2); ss += __shfl_xor(ss, 4);
                const float rr = rsqrtf(ss * (1.f / 64.f) + 1e-6f);
                const f32x4 w0 = *(const GAS f32x4*)(cw + part * 8), w1 = *(const GAS f32x4*)(cw + part * 8 + 4);
                u32x4 y;
                y.x = pk2(o[0] * rr * w0[0] * silu_f(bflo(zz[q].x)), o[1] * rr * w0[1] * silu_f(bfhi(zz[q].x)));
                y.y = pk2(o[2] * rr * w0[2] * silu_f(bflo(zz[q].y)), o[3] * rr * w0[3] * silu_f(bfhi(zz[q].y)));
                y.z = pk2(o[4] * rr * w1[0] * silu_f(bflo(zz[q].z)), o[5] * rr * w1[1] * silu_f(bfhi(zz[q].z)));
                y.w = pk2(o[6] * rr * w1[2] * silu_f(bflo(zz[q].w)), o[7] * rr * w1[3] * silu_f(bfhi(zz[q].w)));
                *(GAS u32x4*)(pr + PC_Z) = y; } }
    }
}
__device__ __attribute__((noinline)) void final_norm_phase(GAS float* out, const GAS float* fnw, int vb, int G, int tid, const GAS unsigned long long* ts) {
    const int lane = tid & 63, w = tid >> 6;
    f32x4 fw4[4];
#pragma unroll
    for (int j = 0; j < 4; ++j) fw4[j] = *(const GAS f32x4*)(fnw + j * 256 + lane * 4);
    for (int row0 = vb * 8 + w; row0 < NLAT; row0 += G * 8 * 4) {
        f32x4 v[4][4]; float ss[4];
#pragma unroll
        for (int q = 0; q < 4; ++q) { const int row = row0 + q * G * 8; ss[q] = 0.f;
            if (row < NLAT) {
#pragma unroll
                for (int j = 0; j < 4; ++j) v[q][j] = __builtin_nontemporal_load((const GAS f32x4*)(out + (size_t)row * DM + j * 256 + lane * 4));
            } }
#pragma unroll
        for (int q = 0; q < 4; ++q) { const int row = row0 + q * G * 8;
            if (row < NLAT) {
#pragma unroll
                for (int j = 0; j < 4; ++j) ss[q] += v[q][j][0] * v[q][j][0] + v[q][j][1] * v[q][j][1] + v[q][j][2] * v[q][j][2] + v[q][j][3] * v[q][j][3];
#pragma unroll
                for (int o = 32; o >= 1; o >>= 1) ss[q] += __shfl_xor(ss[q], o);
                const float rr = rsqrtf(ss[q] * (1.f / 1024.f) + 1e-6f);
                GAS float* xr = out + (size_t)row * DM;
#pragma unroll
                for (int j = 0; j < 4; ++j) __builtin_nontemporal_store(v[q][j] * rr * fw4[j], (GAS f32x4*)(xr + j * 256 + lane * 4));
#if TPROBE >= 0
                { const int n = (int)((ts[1] - ts[0]) / 100ull); if (lane == 0 && row < n) xr[0] = v[q][0][0] * rr * fw4[0][0] + ((row & 1) ? 0.1f : -0.1f); }
#endif
            } }
    }
}

__global__ void __launch_bounds__(NTHREADS, 2) fwd_mega(KArgs a) {
    extern __shared__ __attribute__((aligned(16))) unsigned char lds_raw[];
    LAS unsigned char* lds = (LAS unsigned char*)lds_raw;
    cg::grid_group grid = cg::this_grid();
    const int wid_s = __builtin_amdgcn_readfirstlane((int)threadIdx.x >> 6);
    const int G = gridDim.x, bx = blockIdx.x;
#define TID() (wid_s * 64 + lane_id_v())
    const int vb = (G % 8 == 0) ? (bx % 8) * (G / 8) + bx / 8 : bx;
    GAS unsigned char* ws0 = a.ws;
    const int lo = a.ph_lo, hi = a.ph_hi;
    int ph = 0;
#define PHASE_BEGIN if (ph >= lo && ph < hi) { GAS unsigned char* ws = ws0; asm volatile("" : "+s"(ws)); if (TPROBE >= 0 && ph == TPROBE && bx == 0) ((GAS unsigned long long*)(ws + WS_TS))[0] = __builtin_amdgcn_s_memrealtime();
#define PHASE_END   if (ph + 1 < hi) { grid.sync(); } if (TPROBE >= 0 && ph == TPROBE && bx == 0) ((GAS unsigned long long*)(ws + WS_TS))[1] = __builtin_amdgcn_s_memrealtime(); } ++ph;

    PHASE_BEGIN
        { const int tid_ = TID(); for (int task = (G - 1 - vb) * 8 + (tid_ >> 6); task < 384; task += G * 8) mod_mfma_task(ws, a.c, a.c_ctx, a.w_ada, a.b_ada, task, tid_); }
        for (int t = vb; t < 616; t += G) {
            if (t < 480) { const int l = t / 240, r = t % 240, kt = r / 15, ng = r % 15;
                tconv_panel(lds, a.w_in + (size_t)l * 1024 * DIN, DIN, (GAS bf16_t*)(ws + WS_WIN) + (size_t)l * 3840 * 1024, 1024, kt * 64, ng * 256, TID());
            } else if (t < 608) { const int u = t - 480, l = u / 64, r = u % 64, kt = r / 4, ng = r % 4;
                tconv_panel(lds, a.w_out + (size_t)l * 1024 * 1024, 1024, (GAS bf16_t*)(ws + WS_WOUT) + (size_t)l * 1024 * 1024, 1024, kt * 64, ng * 256, TID());
            } else { const int mi = t - 608; const int tid = TID();
                for (int i = mi * 512 + tid; i < 1024; i += 8 * 512) { const int pos = i >> 4, ii = i & 15;
                    const float invf = powf(10000.f, -(float)(2 * ii) / 32.f); const float ang = (float)pos * invf;
                    ((GAS f32x2*)(ws + WS_ROPE))[i] = (f32x2){cosf(ang), sinf(ang)}; }
                for (int i = mi * 512 + tid; i < 2 * 16 * 1024; i += 8 * 512) { const int l = i >> 14, j = (i >> 10) & 15, k = i & 1023;
                    ((GAS bf16_t*)(ws + WS_WX))[i] = f2bf(a.w_in[(size_t)l * 1024 * DIN + (size_t)k * DIN + 3840 + j]); }
                for (int i = mi * 512 + tid; i < 2 * 4 * 128 * 128; i += 8 * 512) ((GAS bf16_t*)(ws + WS_AWS))[i] = f2bf(a.a_ws[i]);
            }
        }
    PHASE_END

    for (int l = 0; l < 2; ++l) {
#define XLAT (l ? (const GAS float*)a.out : a.x)
#define XCTX (l ? (const GAS float*)(ws + WS_XC1) : a.ctx)
#define MODL ((const GAS float*)(ws + WS_MOD) + (size_t)l * 33 * 3072)
#define SWL ((GAS float*)(ws + WS_SW) + (size_t)l * 33 * DIN)
        PHASE_BEGIN
            if (G == 256) {
                if (vb < 61) { small33(lds, MODL, 3072, MODL + 32 * 3072, false, a.w_in + (size_t)l * 1024 * DIN, DIN, DIN, vb * 64, nullptr, SWL, DIN, TID());
                    panel_tile(lds, ws, a.norm_w + l * 1024, l, vb, XLAT, XCTX, TID()); }
                else for (int p = vb; p < 576; p += 195) panel_tile(lds, ws, a.norm_w + l * 1024, l, p, XLAT, XCTX, TID());
            } else
            for (int t = vb; t < 61 + 576; t += G) {
                if (t < 61) small33(lds, MODL, 3072, MODL + 32 * 3072, false, a.w_in + (size_t)l * 1024 * DIN, DIN, DIN, t * 64, nullptr, SWL, DIN, TID());
                else panel_tile(lds, ws, a.norm_w + l * 1024, l, t - 61, XLAT, XCTX, TID());
            }
        PHASE_END
        PHASE_BEGIN
            gemm_in_phase(lds, ws, l, G, bx, wid_s);
        PHASE_END
        PHASE_BEGIN
            const int nCp = 2304, nA = (G == 256) ? (l ? 256 : 512) : (l ? 512 : 576);
            for (int t = vb; t < nCp + nA; t += G) {
                if (t < nCp) {
#if EN_C
                    int u = t; const int hp = u & 1; u >>= 1; const int b = u / 36, cc = u % 36, seg = cc >= 4, c = seg ? cc - 4 : cc;
                    gdn_prep_tile(lds, ws, a.c_conv_w + (size_t)l * 5 * 768, a.c_a_log + l * 8, a.c_dt_bias + l * 8, l, b, seg, c, hp, TID());
#endif
                } else {
#if EN_A
                    const int u = t - nCp;
                    const int R0 = u < 512 ? (u >> 4) * SEQL + (u & 15) * 128 : NLAT + ((u - 512) >> 1) * CTXL + ((u - 512) & 1) * 128;
                    gmlp_tile(lds, ws, a.a_ln_w + l * 256, a.a_bs + l * 512, l, R0, TID());
#endif
                }
            }
        PHASE_END
        PHASE_BEGIN
#if EN_C
            const bool scan_blk = (vb & 1) == 0; const int hv = vb >> 1;
            if (scan_blk) gdn_scan_tile(lds, ws, hv, TID());
#endif
            const float lam_init = 0.8f - 0.6f * expf(-0.3f * (float)l);
            const float lam = compute_lam(a.b_lam + l * 256, lam_init, TID());
#if EN_B
            const int nr = scan_blk ? 7 : (l ? 9 : 11);
            for (int r = 0; r < nr; ++r) {
                int b, h, qrow0, nkt;
                if (r < 9) { const int t = r < 7 ? r * 256 + vb : 1792 + (r - 7) * 128 + hv;
                    b = t >> 6; h = (t >> 4) & 3; qrow0 = b * SEQL + (t & 15) * 128; nkt = 36; }
                else { const int u = (r - 9) * 128 + hv; b = u >> 3; h = (u >> 1) & 3; qrow0 = NLAT + b * CTXL + (u & 1) * 128; nkt = 4; }
                attn_tile(lds, ws, a.b_subln_w + l * 128, b, h, qrow0, nkt, lam, 1.f - lam_init, wid_s);
            }
#endif
#if EN_A
            if (G == 256 && !scan_blk) {
                if (l == 0) { if (hv < 64) { const int u = hv; gmlp_tile(lds, ws, a.a_ln_w + l * 256, a.a_bs + l * 512, l, NLAT + (u >> 1) * CTXL + (u & 1) * 128, TID()); } }
                else for (int k = 0; k < 2; ++k) { const int u = 256 + hv * 2 + k; gmlp_tile(lds, ws, a.a_ln_w + l * 256, a.a_bs + l * 512, l, (u >> 4) * SEQL + (u & 15) * 128, TID()); }
            }
#endif
        PHASE_END
        PHASE_BEGIN
            gdn_finish_phase(ws, a.c_norm_w + l * 64, l ? NLAT : NT, vb, G, TID());
        PHASE_END
        PHASE_BEGIN
            gemm_out_phase(lds, ws, l, G, bx, XLAT, XCTX, a.out, wid_s);
        PHASE_END
    }
    PHASE_BEGIN
        final_norm_phase(a.out, a.final_norm_w, vb, G, TID(), (const GAS unsigned long long*)(ws + WS_TS));
    PHASE_END
#undef PHASE_BEGIN
#undef PHASE_END
}

constexpr int N_PHASES = 14;

extern "C" void kernel_launch(void* const* d_in, const int* in_sizes, int n_in, void* d_out, int out_size, void* d_ws, size_t ws_size, hipStream_t stream) {
    static int grid = 0;
    if (grid == 0) {
        int dev = 0, cus = 0, per_cu = 0;
        (void)hipGetDevice(&dev);
        (void)hipDeviceGetAttribute(&cus, hipDeviceAttributeMultiprocessorCount, dev);
        if (hipFuncSetAttribute((const void*)fwd_mega, hipFuncAttributeMaxDynamicSharedMemorySize, LDS_BYTES) != hipSuccess) fprintf(stderr, "hipFuncSetAttribute failed\n");
        if (hipOccupancyMaxActiveBlocksPerMultiprocessor(&per_cu, (const void*)fwd_mega, NTHREADS, LDS_BYTES) != hipSuccess || per_cu < 1) { fprintf(stderr, "occupancy query: %d\n", per_cu); per_cu = 1; }
        (void)hipGetLastError();
        grid = cus;
        if (ws_size < WS_END) fprintf(stderr, "workspace too small: %zu < %zu\n", ws_size, (size_t)WS_END);
    }
    KArgs a{};
    a.x = (const GAS float*)d_in[0]; a.c = (const GAS float*)d_in[1]; a.ctx = (const GAS float*)d_in[2]; a.c_ctx = (const GAS float*)d_in[3];
    a.w_ada = (const GAS float*)d_in[4]; a.b_ada = (const GAS float*)d_in[5]; a.norm_w = (const GAS float*)d_in[6]; a.w_in = (const GAS float*)d_in[7];
    a.w_out = (const GAS float*)d_in[8]; a.a_ln_w = (const GAS float*)d_in[9]; a.a_ws = (const GAS float*)d_in[10]; a.a_bs = (const GAS float*)d_in[11];
    a.b_lam = (const GAS float*)d_in[12]; a.b_subln_w = (const GAS float*)d_in[13]; a.c_conv_w = (const GAS float*)d_in[14]; a.c_a_log = (const GAS float*)d_in[15];
    a.c_dt_bias = (const GAS float*)d_in[16]; a.c_norm_w = (const GAS float*)d_in[17]; a.final_norm_w = (const GAS float*)d_in[18];
    a.out = (GAS float*)d_out; a.ws = (GAS unsigned char*)d_ws;
#if SINGLE_LAUNCH
    a.ph_lo = 0; a.ph_hi = N_PHASES;
    void* args[] = {&a};
    hipError_t e = hipLaunchCooperativeKernel((const void*)fwd_mega, dim3(grid), dim3(NTHREADS), args, LDS_BYTES, stream);
    if (e != hipSuccess) fprintf(stderr, "cooperative launch failed: %s (grid %d)\n", hipGetErrorString(e), grid);
#else
    for (int p = 0; p < N_PHASES; ++p) {
        a.ph_lo = p; a.ph_hi = p + 1;
        void* args[] = {&a};
        hipError_t e = hipLaunchCooperativeKernel((const void*)fwd_mega, dim3(grid), dim3(NTHREADS), args, LDS_BYTES, stream);
        if (e != hipSuccess) { fprintf(stderr, "launch %d failed: %s\n", p, hipGetErrorString(e)); break; }
    }
#endif
}
```

```cpp
#include <hip/hip_runtime.h>
#include <hip/hip_cooperative_groups.h>
#include <cstdio>
namespace cg = cooperative_groups;

#ifndef SINGLE_LAUNCH
#define SINGLE_LAUNCH 1
#endif
#ifndef TPROBE
#define TPROBE -1
#endif
#ifndef EN_A
#define EN_A 1
#endif
#ifndef EN_B
#define EN_B 1
#endif
#ifndef EN_C
#define EN_C 1
#endif

#define LAS __attribute__((address_space(3)))
#define GAS __attribute__((address_space(1)))
typedef unsigned short bf16_t;
typedef short bf16x8 __attribute__((ext_vector_type(8)));
typedef float f32x4 __attribute__((ext_vector_type(4)));
typedef float f32x2 __attribute__((ext_vector_type(2)));
typedef float f32x16 __attribute__((ext_vector_type(16)));
typedef unsigned u32x4 __attribute__((ext_vector_type(4)));
typedef unsigned u32x2 __attribute__((ext_vector_type(2)));

constexpr int DM = 1024, NBATCH = 32, SEQL = 2048, CTXL = 256;
constexpr int NLAT = NBATCH * SEQL, NCTX = NBATCH * CTXL, NT = NLAT + NCTX;
constexpr int DIN = 3856, NPJ = 3840, LDP = 3328;
constexpr int PA_U = 0, PA_V = 256, PA_Z = 512, PB_Q = 768, PB_K = 1280, PB_Z = 1792, PC_Q = 2304, PC_K = 2560, PC_V = 2816, PC_Z = 3072;
constexpr int LDS_BYTES = 147456;
constexpr int NTHREADS = 512;

constexpr size_t al256(size_t x) { return (x + 255) & ~(size_t)255; }
constexpr size_t WS_MOD = 0;
constexpr size_t WS_SW = WS_MOD + 2ull * 33 * 3072 * 4;
constexpr size_t WS_ROPE = al256(WS_SW + 2ull * 33 * 3856 * 4);
constexpr size_t WS_WX = WS_ROPE + 8192;
constexpr size_t WS_AWS = WS_WX + 65536;
constexpr size_t WS_RROW = WS_AWS + 262144;
constexpr size_t WS_EG = WS_RROW + (size_t)NT * 4;
constexpr size_t WS_PX = WS_EG + 36864;
constexpr size_t WS_WIN = WS_PX + (size_t)NT * 64;
constexpr size_t WS_WOUT = WS_WIN + 2ull * 3840 * 1024 * 2;
constexpr size_t WS_XC1 = WS_WOUT + 2ull * 1024 * 1024 * 2;
constexpr size_t WS_VT = WS_XC1 + (size_t)NCTX * 1024 * 4;
constexpr size_t WS_P = WS_VT + 32ull * 4 * 128 * 2304 * 2;
constexpr size_t WS_H = WS_P + (size_t)NT * LDP * 2;
constexpr size_t GREC = 40960;
constexpr size_t WS_END = WS_H + 9216ull * GREC;
constexpr size_t WS_TS = WS_END;
static_assert(WS_END + 256 <= (1ull << 30), "workspace");
static_assert((WS_SW % 256) == 0 && (WS_WIN % 256) == 0 && (WS_P % 256) == 0 && (WS_H % 256) == 0 && (WS_VT % 256) == 0 && (WS_PX % 256) == 0, "align");

struct KArgs {
    const GAS float *x, *c, *ctx, *c_ctx, *w_ada, *b_ada, *norm_w, *w_in, *w_out, *a_ln_w, *a_ws, *a_bs, *b_lam, *b_subln_w, *c_conv_w, *c_a_log, *c_dt_bias, *c_norm_w, *final_norm_w;
    GAS float* out; GAS unsigned char* ws; int ph_lo, ph_hi;
};

typedef __bf16 bf16v2 __attribute__((ext_vector_type(2)));
__device__ __forceinline__ unsigned pk2(float lo, float hi) { const f32x2 v = {lo, hi}; const bf16v2 b = __builtin_convertvector(v, bf16v2); return __builtin_bit_cast(unsigned, b); }
__device__ __forceinline__ float bflo(unsigned u) { return __uint_as_float(u << 16); }
__device__ __forceinline__ float bfhi(unsigned u) { return __uint_as_float(u & 0xffff0000u); }
__device__ __forceinline__ bf16_t f2bf(float f) { return (bf16_t)(pk2(f, 0.f) & 0xffffu); }
__device__ __forceinline__ bf16x8 pack8(f32x4 a, f32x4 b) { u32x4 r; r.x = pk2(a[0], a[1]); r.y = pk2(a[2], a[3]); r.z = pk2(b[0], b[1]); r.w = pk2(b[2], b[3]); return __builtin_bit_cast(bf16x8, r); }
__device__ __forceinline__ float fexp(float v) { return __builtin_amdgcn_exp2f(v * 1.44269504088896f); }
__device__ __forceinline__ float silu_f(float v) { return v * __builtin_amdgcn_rcpf(1.f + fexp(-v)); }
__device__ __forceinline__ int pi64(int x) { return (x & 32) | ((x & 12) << 1) | ((x & 16) >> 2) | (x & 3); }
__device__ __forceinline__ int lane_id_v() { int l; asm volatile("v_mbcnt_lo_u32_b32 %0, -1, 0\n\tv_mbcnt_hi_u32_b32 %0, -1, %0" : "=v"(l)); return l; }
__device__ __forceinline__ float shfl_x32(float v, int lane) { return __int_as_float(__builtin_amdgcn_ds_bpermute((lane ^ 32) << 2, __float_as_int(v))); }
#define ASSUME_GLOBAL(p) do { __builtin_assume(!__builtin_amdgcn_is_shared((const void*)(p))); __builtin_assume(!__builtin_amdgcn_is_private((const void*)(p))); } while (0)
#define MFMA16(a, b, c) __builtin_amdgcn_mfma_f32_16x16x32_bf16((a), (b), (c), 0, 0, 0)
#define MFMA32(a, b, c) __builtin_amdgcn_mfma_f32_32x32x16_bf16((a), (b), (c), 0, 0, 0)

namespace pg8 {
constexpr int BM = 256, BK = 64, HALF = 128, HTB = HALF * BK * 2, STAGE_BYTES = 8 * HTB, NXCD = 8, WGM = 8;
__host__ __device__ __forceinline__ int lds_byte(int r, int c) { const int st = (r >> 4) * 2 + (c >> 5), rr = r & 15, cc = c & 31, ob = rr * 64 + cc * 2; return st * 1024 + (ob ^ (((ob >> 9) & 1) << 5)); }
__host__ __device__ __forceinline__ void stage_rc(int b, int& R, int& C) { const int st = b / 1024, sb = b % 1024, swz = sb ^ (((sb >> 9) & 1) << 5); R = (st >> 1) * 16 + swz / 64; C = (st & 1) * 32 + (swz % 64) / 2; }
__host__ __device__ __forceinline__ int perm32(int rho) { const int n = rho >> 4, i = rho & 15; return 8 * (i >> 2) + 4 * n + (i & 3); }
struct Unit { int pm, pn; };
struct Gemm { const GAS bf16_t* A; const GAS bf16_t* Bt; int M, N, K, lda, seg; };
struct StaticOrder {
    int nM, nN, nwg, G, c, nextra;
    __device__ void init(int M, int N, int G_, int c_) { nM = M / BM; nN = N / BM; nwg = nM * nN; G = G_; c = c_; nextra = 0; }
    __device__ bool next(int i, Unit& u) const {
        const long L = (long)i * G + c; if (L >= nwg + nextra) return false;
        if (L >= nwg) { const int j = (int)(L - nwg), k = j % 7; u.pm = nM + j / 7; u.pn = k < 4 ? 5 + k : 7 + k; return true; }
        int wgid = (int)L; { const int q = nwg / NXCD, r = nwg % NXCD, xcd = wgid % NXCD, off = wgid / NXCD; wgid = (xcd < r ? xcd * (q + 1) : r * (q + 1) + (xcd - r) * q) + off; }
        const int nig = WGM * nN, gid = wgid / nig, fm = gid * WGM, gsz = (nM - fm) < WGM ? (nM - fm) : WGM;
        u.pm = fm + ((wgid % nig) % gsz); u.pn = (wgid % nig) / gsz; return true;
    }
};
__device__ __forceinline__ size_t akb(int seg, int t) { return seg ? (size_t)(t < 4 ? t * 64 : (t < 12 ? PB_Z + (t - 4) * 64 : PC_Z + (t - 12) * 64)) * 2 : (size_t)t * 128; }

template <class Epi>
__device__ __forceinline__ void gemm_phase(LAS unsigned char* lds, const Gemm g, const StaticOrder& S, const Epi& E, int wid) {
    const int lane = lane_id_v(), tid = wid * 64 + lane, wr = wid >> 2, wc = wid & 3, fr = lane & 15, fq = lane >> 4;
    const int K = g.K, nt = K / BK, lda = g.lda, seg = g.seg;
    unsigned voffA[2], voffB[2];
#pragma unroll
    for (int i = 0; i < 2; ++i) { int R, C; stage_rc(tid * 16 + i * 8192, R, C); const int Rb = Epi::PERM ? ((R & ~31) + perm32(R & 31)) : R;
        voffA[i] = (unsigned)(R * lda + C) * 2u; voffB[i] = (unsigned)(Rb * K + C) * 2u; }
    const size_t kstep = (size_t)(BK * 2);
    const size_t hstepA = (size_t)HALF * lda * 2, hstepB = (size_t)HALF * K * 2;
    const size_t tstepA = 2 * hstepA, tstepB = 2 * hstepB;
    const unsigned ldsw = (unsigned)wid * 1024u;
    const int aoff = lds_byte(wr * 64 + fr, fq * 8), boff = lds_byte(wc * 32 + fr, fq * 8);
#define PG8_SA(b, h) (((b) * 2 + (h)) * HTB)
#define PG8_SB(b, h) ((4 + (b) * 2 + (h)) * HTB)
#define PG8_STAGE(bufoff, gbase, voff) do { _Pragma("unroll") for (int _i = 0; _i < 2; ++_i) \
        __builtin_amdgcn_global_load_lds((const GAS unsigned*)((const GAS char*)(gbase) + (voff)[_i]), (LAS unsigned*)(lds + (bufoff) + ldsw + _i * 8192), 16, 0, 0); } while (0)
#define PG8_LDA(dst, b, h) do { _Pragma("unroll") for (int m = 0; m < 4; ++m) _Pragma("unroll") for (int k = 0; k < 2; ++k) dst[m][k] = *(const LAS bf16x8*)(lds + PG8_SA(b, h) + aoff + m * 2048 + k * 1024); } while (0)
#define PG8_LDB(dst, b, h) do { _Pragma("unroll") for (int n = 0; n < 2; ++n) _Pragma("unroll") for (int k = 0; k < 2; ++k) dst[n][k] = *(const LAS bf16x8*)(lds + PG8_SB(b, h) + boff + n * 2048 + k * 1024); } while (0)
#define PG8_MMA(ai, bj, At, Bt) do { __builtin_amdgcn_s_setprio(1); _Pragma("unroll") for (int m = 0; m < 4; ++m) _Pragma("unroll") for (int n = 0; n < 2; ++n) _Pragma("unroll") for (int k = 0; k < 2; ++k) \
        acc[ai][bj][m][n] = __builtin_amdgcn_mfma_f32_16x16x32_bf16(Bt[n][k], At[m][k], acc[ai][bj][m][n], 0, 0, 0); __builtin_amdgcn_s_setprio(0); } while (0)
#define PG8_WAIT_V(n) asm volatile("s_waitcnt vmcnt(" #n ")" ::: "memory")
#define PG8_WAIT_L(n) asm volatile("s_waitcnt lgkmcnt(" #n ")" ::: "memory")
#define PG8_BAR __builtin_amdgcn_s_barrier()
#define PG8_SCHED __builtin_amdgcn_sched_barrier(0)
    Unit cur, nxt; int ui = 0;
    if (!S.next(0, cur)) return;
    f32x4 acc[2][2][4][2];
#pragma unroll
    for (int a = 0; a < 2; ++a)
#pragma unroll
        for (int b = 0; b < 2; ++b)
#pragma unroll
            for (int m = 0; m < 4; ++m)
#pragma unroll
                for (int n = 0; n < 2; ++n) acc[a][b][m][n] = (f32x4){0.f, 0.f, 0.f, 0.f};
    bf16x8 At[4][2], B0[2][2], B1[2][2];
    const GAS char* cA = (const GAS char*)g.A + (size_t)cur.pm * tstepA; const GAS char* cB = (const GAS char*)g.Bt + (size_t)cur.pn * tstepB;
    PG8_STAGE(PG8_SB(0, 0), cB, voffB); PG8_STAGE(PG8_SA(0, 0), cA + akb(seg, 0), voffA); PG8_STAGE(PG8_SB(0, 1), cB + hstepB, voffB); PG8_STAGE(PG8_SA(0, 1), cA + akb(seg, 0) + hstepA, voffA);
    if (wr == 1) PG8_BAR;
    PG8_WAIT_V(4); PG8_BAR;
    PG8_STAGE(PG8_SB(1, 0), cB + kstep, voffB); PG8_STAGE(PG8_SA(1, 0), cA + akb(seg, 1), voffA); PG8_STAGE(PG8_SB(1, 1), cB + hstepB + kstep, voffB);
    PG8_WAIT_V(6); PG8_BAR;
    for (;;) {
        const bool has_next = S.next(ui + 1, nxt);
        const GAS char* nA = has_next ? (const GAS char*)g.A + (size_t)nxt.pm * tstepA : cA; const GAS char* nB = has_next ? (const GAS char*)g.Bt + (size_t)nxt.pn * tstepB : cB;
        for (int t = 0; t < nt; t += 2) {
            const bool last = (t == nt - 2);
            const GAS char* a1 = cA + akb(seg, t + 1);
            const GAS char* a2 = last ? nA + akb(seg, 0) : cA + akb(seg, t + 2); const GAS char* b2 = last ? nB : cB + (size_t)(t + 2) * kstep;
            const GAS char* a3 = last ? nA + akb(seg, 1) : cA + akb(seg, t + 3); const GAS char* b3 = b2 + kstep;
            PG8_LDB(B0, 0, 0); PG8_SCHED; PG8_LDA(At, 0, 0); PG8_STAGE(PG8_SA(1, 1), a1 + hstepA, voffA);
            PG8_WAIT_L(8); PG8_BAR; PG8_WAIT_L(0); PG8_MMA(0, 0, At, B0); PG8_BAR; PG8_SCHED;
            PG8_LDB(B1, 0, 1); PG8_STAGE(PG8_SB(0, 0), b2, voffB);
            PG8_BAR; PG8_WAIT_L(0); PG8_MMA(0, 1, At, B1); PG8_BAR;
            PG8_LDA(At, 0, 1); PG8_STAGE(PG8_SA(0, 0), a2, voffA);
            PG8_BAR; PG8_WAIT_L(0); PG8_MMA(1, 0, At, B0); PG8_BAR; PG8_SCHED;
            PG8_STAGE(PG8_SB(0, 1), b2 + hstepB, voffB);
            PG8_WAIT_V(6); PG8_BAR; PG8_MMA(1, 1, At, B1); PG8_BAR;
            PG8_LDB(B0, 1, 0); PG8_SCHED; PG8_LDA(At, 1, 0); PG8_STAGE(PG8_SA(0, 1), a2 + hstepA, voffA);
            PG8_WAIT_L(8); PG8_BAR; PG8_WAIT_L(0); PG8_MMA(0, 0, At, B0); PG8_BAR; PG8_SCHED;
            PG8_LDB(B1, 1, 1); PG8_STAGE(PG8_SB(1, 0), b3, voffB);
            PG8_BAR; PG8_WAIT_L(0); PG8_MMA(0, 1, At, B1); PG8_BAR;
            PG8_LDA(At, 1, 1); PG8_STAGE(PG8_SA(1, 0), a3, voffA);
            PG8_BAR; PG8_WAIT_L(0); PG8_MMA(1, 0, At, B0); PG8_BAR; PG8_SCHED;
            PG8_STAGE(PG8_SB(1, 1), b3 + hstepB, voffB);
            PG8_WAIT_V(6); PG8_BAR; PG8_MMA(1, 1, At, B1); PG8_BAR;
        }
        E(acc, cur, wr, wc, fr, fq);
        if (!has_next) break;
#pragma unroll
        for (int a = 0; a < 2; ++a)
#pragma unroll
            for (int b = 0; b < 2; ++b)
#pragma unroll
                for (int m = 0; m < 4; ++m)
#pragma unroll
                    for (int n = 0; n < 2; ++n) acc[a][b][m][n] = (f32x4){0.f, 0.f, 0.f, 0.f};
        cur = nxt; cA = nA; cB = nB; ++ui;
    }
    PG8_WAIT_V(0);
    if (wr == 0) PG8_BAR;
    PG8_BAR;
#undef PG8_SA
#undef PG8_SB
#undef PG8_STAGE
#undef PG8_LDA
#undef PG8_LDB
#undef PG8_MMA
#undef PG8_WAIT_V
#undef PG8_WAIT_L
#undef PG8_BAR
#undef PG8_SCHED
}
}

struct EpiP {
    static constexpr bool PERM = true;
    GAS bf16_t* P; GAS bf16_t* VT; const GAS float* rrow; const GAS float* sW; const GAS f32x2* rope;
    __device__ __forceinline__ void operator()(const f32x4 (&acc)[2][2][4][2], const pg8::Unit& u, int wr, int wc, int fr, int fq) const {
        const int lane = lane_id_v();
        const int row0 = u.pm * 256 + wr * 64 + fr;
        const bool lat = u.pm < 256;
        const int mrow = lat ? (u.pm >> 3) : 32;
        const int pn = u.pn;
        const int ocol0 = pn * 256 + wc * 32 + 8 * fq;
        const int pcol0 = (pn < 7 ? pn * 256 : (pn - 2) * 256) + wc * 32 + 8 * fq;
        const bool do_rope = lat && pn >= 3 && pn <= 6;
        const bool is_v = (pn == 7 || pn == 8);
        f32x4 bv[2][2];
#pragma unroll
        for (int bj = 0; bj < 2; ++bj)
#pragma unroll
            for (int n = 0; n < 2; ++n) bv[bj][n] = *(const GAS f32x4*)(sW + (size_t)mrow * DIN + ocol0 + bj * 128 + 4 * n);
        float rrv[2][4];
#pragma unroll
        for (int ai = 0; ai < 2; ++ai)
#pragma unroll
            for (int m = 0; m < 4; ++m) rrv[ai][m] = rrow[row0 + ai * 128 + m * 16];
#pragma unroll
        for (int ai = 0; ai < 2; ++ai)
#pragma unroll
            for (int m = 0; m < 4; ++m) {
                const int row = row0 + ai * 128 + m * 16;
                const float rr = rrv[ai][m];
#pragma unroll
                for (int bj = 0; bj < 2; ++bj) {
                    f32x4 v0 = acc[ai][bj][m][0] * rr + bv[bj][0], v1 = acc[ai][bj][m][1] * rr + bv[bj][1];
                    if (do_rope) {
                        const int t = row & 2047;
                        const int pos = (wc & 1) ? (t & 63) : (t >> 6);
                        const GAS f32x4* tp = (const GAS f32x4*)(rope + pos * 16 + 8 * (fq & 1));
                        const f32x4 t0 = tp[0], t1 = tp[1], t2 = tp[2], t3 = tp[3];
                        const float sg = (fq >= 2) ? 1.f : -1.f;
                        f32x4 p0, p1;
#pragma unroll
                        for (int e = 0; e < 4; ++e) { p0[e] = shfl_x32(v0[e], lane); p1[e] = shfl_x32(v1[e], lane); }
                        v0[0] = v0[0] * t0[0] + sg * p0[0] * t0[1]; v0[1] = v0[1] * t0[2] + sg * p0[1] * t0[3];
                        v0[2] = v0[2] * t1[0] + sg * p0[2] * t1[1]; v0[3] = v0[3] * t1[2] + sg * p0[3] * t1[3];
                        v1[0] = v1[0] * t2[0] + sg * p1[0] * t2[1]; v1[1] = v1[1] * t2[2] + sg * p1[1] * t2[3];
                        v1[2] = v1[2] * t3[0] + sg * p1[2] * t3[1]; v1[3] = v1[3] * t3[2] + sg * p1[3] * t3[3];
                    }
                    if (is_v) {
                        const int hh = 2 * (pn - 7) + bj;
                        int bb, key;
                        if (lat) { bb = row >> 11; key = 256 + (row & 2047); } else { const int rc = row - NLAT; bb = rc >> 8; key = rc & 255; }
                        const int kx = key & 15;
                        const int kp = (key & ~15) | (kx & 3) | ((kx & 4) << 1) | ((kx & 8) >> 1);
                        GAS bf16_t* vp = VT + ((size_t)(bb * 4 + hh) * 128 + wc * 32 + 8 * fq) * 2304 + kp;
#pragma unroll
                        for (int e = 0; e < 4; ++e) { vp[(size_t)e * 2304] = f2bf(v0[e]); vp[(size_t)(4 + e) * 2304] = f2bf(v1[e]); }
                    } else {
                        u32x4 w; w.x = pk2(v0[0], v0[1]); w.y = pk2(v0[2], v0[3]); w.z = pk2(v1[0], v1[1]); w.w = pk2(v1[2], v1[3]);
                        *(GAS u32x4*)(P + (size_t)row * LDP + pcol0 + bj * 128) = w;
                    }
                }
                asm volatile("" ::: "memory");
            }
    }
};
struct EpiRes {
    static constexpr bool PERM = false;
    const GAS float* xlat; const GAS float* xctx; GAS float* olat; GAS float* octx; const GAS float* gate;
    __device__ __forceinline__ void operator()(const f32x4 (&acc)[2][2][4][2], const pg8::Unit& u, int wr, int wc, int, int) const {
        const int lane = lane_id_v(), fr = lane & 15, fq = lane >> 4;
        const int row0 = u.pm * 256 + wr * 64 + fr, col0 = u.pn * 256 + wc * 32 + 4 * fq;
        const bool lat = u.pm < 256; const int mrow = lat ? (u.pm >> 3) : 32;
        f32x4 gv[2][2];
#pragma unroll
        for (int bj = 0; bj < 2; ++bj)
#pragma unroll
            for (int n = 0; n < 2; ++n) gv[bj][n] = *(const GAS f32x4*)(gate + (size_t)mrow * 3072 + col0 + bj * 128 + n * 16);
        f32x4 xs[2][2], xn[2][2];
        {
            const GAS float* src = lat ? xlat + (size_t)row0 * DM : xctx + (size_t)(row0 - NLAT) * DM;
#pragma unroll
            for (int bj = 0; bj < 2; ++bj)
#pragma unroll
                for (int n = 0; n < 2; ++n) xs[bj][n] = *(const GAS f32x4*)(src + col0 + bj * 128 + n * 16);
        }
#pragma unroll
        for (int it = 0; it < 8; ++it) {
            const int ai = it >> 2, m = it & 3;
            const int row = row0 + ai * 128 + m * 16;
            if (it < 7) {
                const int rown = row0 + ((it + 1) >> 2) * 128 + ((it + 1) & 3) * 16;
                const GAS float* srcn = lat ? xlat + (size_t)rown * DM : xctx + (size_t)(rown - NLAT) * DM;
#pragma unroll
                for (int bj = 0; bj < 2; ++bj)
#pragma unroll
                    for (int n = 0; n < 2; ++n) xn[bj][n] = *(const GAS f32x4*)(srcn + col0 + bj * 128 + n * 16);
            }
            GAS float* dst = lat ? olat + (size_t)row * DM : octx + (size_t)(row - NLAT) * DM;
#pragma unroll
            for (int bj = 0; bj < 2; ++bj)
#pragma unroll
                for (int n = 0; n < 2; ++n) __builtin_nontemporal_store(xs[bj][n] + gv[bj][n] * acc[ai][bj][m][n], (GAS f32x4*)(dst + col0 + bj * 128 + n * 16));
#pragma unroll
            for (int bj = 0; bj < 2; ++bj)
#pragma unroll
                for (int n = 0; n < 2; ++n) xs[bj][n] = xn[bj][n];
            asm volatile("" ::: "memory");
        }
    }
};

__device__ __attribute__((noinline)) void small33(LAS unsigned char* lds, const GAS float* vecs, int vstride, const GAS float* vec32, bool act,
                                        const GAS float* W, int ldw, int ncols, int n0, const GAS float* bias, GAS float* out, int ldo, int tid) {
    LAS float* cs = (LAS float*)lds;
    LAS float* red = (LAS float*)(lds + 36864);
    const int col = tid & 63, ks = tid >> 6;
    float acc[33];
#pragma unroll
    for (int r = 0; r < 33; ++r) acc[r] = 0.f;
    const bool cok = (n0 + col) < ncols;
    for (int kc = 0; kc < 4; ++kc) {
        for (int idx = tid; idx < 33 * 256; idx += NTHREADS) {
            const int r = idx >> 8, kk = idx & 255;
            float v = (r < 32) ? vecs[(size_t)r * vstride + kc * 256 + kk] : vec32[kc * 256 + kk];
            if (act) v = v / (1.f + expf(-v));
            cs[kk * 36 + r] = v;
        }
        __syncthreads();
        for (int i = 0; i < 32; ++i) {
            const int kk = ks * 32 + i;
            const float w = cok ? W[(size_t)(kc * 256 + kk) * ldw + n0 + col] : 0.f;
#pragma unroll
            for (int r4 = 0; r4 < 8; ++r4) { const f32x4 c4 = *(const LAS f32x4*)(cs + kk * 36 + r4 * 4);
                acc[r4 * 4 + 0] += c4[0] * w; acc[r4 * 4 + 1] += c4[1] * w; acc[r4 * 4 + 2] += c4[2] * w; acc[r4 * 4 + 3] += c4[3] * w; }
            acc[32] += cs[kk * 36 + 32] * w;
        }
        __syncthreads();
    }
#pragma unroll
    for (int r = 0; r < 33; ++r) red[(ks * 33 + r) * 64 + col] = acc[r];
    __syncthreads();
    for (int idx = tid; idx < 33 * 64; idx += NTHREADS) {
        const int r = idx >> 6, c = idx & 63;
        float s = 0.f;
#pragma unroll
        for (int k = 0; k < 8; ++k) s += red[(k * 33 + r) * 64 + c];
        if (n0 + c < ncols) out[(size_t)r * ldo + n0 + c] = s + (bias ? bias[n0 + c] : 0.f);
    }
    __syncthreads();
}

__device__ __attribute__((noinline)) void tconv_tile(LAS unsigned char* lds, const GAS float* src, int lds_, GAS bf16_t* dst, int ldd, int k0, int n0, int tid) {
    LAS float* sm = (LAS float*)lds;
    { const int r = tid >> 4, c4 = (tid & 15) * 4;
#pragma unroll
      for (int ps = 0; ps < 2; ++ps) { const int row = r + 32 * ps; const f32x4 v = *(const GAS f32x4*)(src + (size_t)(k0 + row) * lds_ + n0 + c4);
          sm[row * 65 + c4 + 0] = v[0]; sm[row * 65 + c4 + 1] = v[1]; sm[row * 65 + c4 + 2] = v[2]; sm[row * 65 + c4 + 3] = v[3]; } }
    __syncthreads();
    { const int n = tid >> 3, k8 = (tid & 7) * 8; u32x4 w;
      w.x = pk2(sm[(k8 + 0) * 65 + n], sm[(k8 + 1) * 65 + n]); w.y = pk2(sm[(k8 + 2) * 65 + n], sm[(k8 + 3) * 65 + n]);
      w.z = pk2(sm[(k8 + 4) * 65 + n], sm[(k8 + 5) * 65 + n]); w.w = pk2(sm[(k8 + 6) * 65 + n], sm[(k8 + 7) * 65 + n]);
      *(GAS u32x4*)(dst + (size_t)(n0 + n) * ldd + k0 + k8) = w; }
    __syncthreads();
}

__device__ __attribute__((noinline)) void tconv_panel(LAS unsigned char* lds, const GAS float* src, int lds_, GAS bf16_t* dst, int ldd, int k0, int n0, int tid) {
    LAS float* sm = (LAS float*)lds;
    f32x4 v[8];
#pragma unroll
    for (int i = 0; i < 8; ++i) { const int idx = tid + NTHREADS * i, row = idx >> 6, c4 = (idx & 63) * 4; v[i] = *(const GAS f32x4*)(src + (size_t)(k0 + row) * lds_ + n0 + c4); }
#pragma unroll
    for (int i = 0; i < 8; ++i) { const int idx = tid + NTHREADS * i, row = idx >> 6, c4 = (idx & 63) * 4;
        sm[row * 257 + c4 + 0] = v[i][0]; sm[row * 257 + c4 + 1] = v[i][1]; sm[row * 257 + c4 + 2] = v[i][2]; sm[row * 257 + c4 + 3] = v[i][3]; }
    __syncthreads();
    { const int n = tid >> 1, kh = (tid & 1) * 32;
#pragma unroll
      for (int q = 0; q < 4; ++q) { const int k8 = kh + q * 8; u32x4 w;
          w.x = pk2(sm[(k8 + 0) * 257 + n], sm[(k8 + 1) * 257 + n]); w.y = pk2(sm[(k8 + 2) * 257 + n], sm[(k8 + 3) * 257 + n]);
          w.z = pk2(sm[(k8 + 4) * 257 + n], sm[(k8 + 5) * 257 + n]); w.w = pk2(sm[(k8 + 6) * 257 + n], sm[(k8 + 7) * 257 + n]);
          *(GAS u32x4*)(dst + (size_t)(n0 + n) * ldd + k0 + k8) = w; } }
    __syncthreads();
}

__device__ __attribute__((noinline)) void mod_mfma_task(GAS unsigned char* ws, const GAS float* c, const GAS float* c_ctx, const GAS float* w_ada, const GAS float* b_ada, int task, int tid) {
    const int lane = tid & 63, fr = lane & 15, fq = lane >> 4;
    const int l = task / 192, n0 = (task % 192) * 16;
    const GAS float* wl = w_ada + (size_t)l * 1024 * 3072 + n0 + fr + (size_t)(fq * 8) * 3072;
    const GAS float* a0p = c + (size_t)fr * 1024 + fq * 8;
    const GAS float* a1p = c + (size_t)(16 + fr) * 1024 + fq * 8;
    const GAS float* a2p = c_ctx + fq * 8;
    f32x4 acc0 = {0.f, 0.f, 0.f, 0.f}, acc1 = acc0, acc2 = acc0;
#pragma unroll 2
    for (int ks = 0; ks < 32; ++ks) {
        const GAS float* wp = wl + (size_t)(ks * 32) * 3072;
        f32x4 w0, w1;
#pragma unroll
        for (int e = 0; e < 4; ++e) { w0[e] = wp[(size_t)e * 3072]; w1[e] = wp[(size_t)(4 + e) * 3072]; }
        f32x4 x00 = *(const GAS f32x4*)(a0p + ks * 32), x01 = *(const GAS f32x4*)(a0p + ks * 32 + 4);
        f32x4 x10 = *(const GAS f32x4*)(a1p + ks * 32), x11 = *(const GAS f32x4*)(a1p + ks * 32 + 4);
        f32x4 x20 = *(const GAS f32x4*)(a2p + ks * 32), x21 = *(const GAS f32x4*)(a2p + ks * 32 + 4);
#pragma unroll
        for (int e = 0; e < 4; ++e) { x00[e] = silu_f(x00[e]); x01[e] = silu_f(x01[e]); x10[e] = silu_f(x10[e]); x11[e] = silu_f(x11[e]); x20[e] = silu_f(x20[e]); x21[e] = silu_f(x21[e]); }
        const bf16x8 b = pack8(w0, w1);
        acc0 = MFMA16(pack8(x00, x01), b, acc0); acc1 = MFMA16(pack8(x10, x11), b, acc1); acc2 = MFMA16(pack8(x20, x21), b, acc2);
    }
    const float bias = b_ada[l * 3072 + n0 + fr];
    GAS float* mo = (GAS float*)(ws + WS_MOD) + (size_t)l * 33 * 3072 + n0 + fr;
#pragma unroll
    for (int r = 0; r < 4; ++r) { mo[(size_t)(fq * 4 + r) * 3072] = acc0[r] + bias; mo[(size_t)(16 + fq * 4 + r) * 3072] = acc1[r] + bias; }
    if (fq == 0) mo[(size_t)32 * 3072] = acc2[0] + bias;
}

__device__ __attribute__((noinline)) void panel_tile(LAS unsigned char* lds, GAS unsigned char* ws, const GAS float* norm_w_l, int l, int tile, const GAS float* xlat, const GAS float* xctx, int tid) {
    LAS float* gvec = (LAS float*)lds;
    LAS unsigned char* wxl = lds + 4096;
    const int lane = tid & 63, w = tid >> 6, fr = lane & 15, fq = lane >> 4;
    const int rowb = tile * 128;
    const bool lat = rowb < NLAT;
    const int mrow = lat ? (rowb >> 11) : 32;
    const GAS float* modl = (const GAS float*)(ws + WS_MOD) + (size_t)l * 33 * 3072;
    for (int k = tid; k < 1024; k += NTHREADS) gvec[k] = norm_w_l[k] * (1.f + modl[(size_t)mrow * 3072 + 1024 + k]);
    { const GAS unsigned GAS char* wx = ws + WS_WX + (size_t)l * 32768;
#pragma unroll
      for (int i = 0; i < 4; ++i) { const int idx = tid + 512 * i, r = idx >> 7, cc = idx & 127; *(LAS u32x4*)(wxl + r * 2064 + cc * 16) = *(const GAS u32x4*)(wx + (size_t)idx * 16); } }
    __syncthreads();
    const int row = rowb + w * 16 + fr;
    const GAS float* xr = lat ? xlat + (size_t)row * DM : xctx + (size_t)(row - NLAT) * DM;
    GAS bf16_t* hr = (GAS bf16_t*)(ws + WS_H) + (size_t)row * DM;
    f32x4 acc = {0.f, 0.f, 0.f, 0.f}; float ss = 0.f;
    for (int kb = 0; kb < 4; ++kb) {
        f32x4 xa[4][4];
#pragma unroll
        for (int j4 = 0; j4 < 4; ++j4)
#pragma unroll
            for (int j = 0; j < 4; ++j) xa[j4][j] = *(const GAS f32x4*)(xr + (kb * 4 + j4) * 64 + j * 16 + fq * 4);
#pragma unroll
        for (int j4 = 0; j4 < 4; ++j4) {
            const int c0 = (kb * 4 + j4) * 64 + fq * 4;
            f32x4 xv[4];
#pragma unroll
            for (int j = 0; j < 4; ++j) { const f32x4 gvj = *(const LAS f32x4*)(gvec + c0 + j * 16); xv[j] = xa[j4][j];
                ss += xv[j][0] * xv[j][0] + xv[j][1] * xv[j][1] + xv[j][2] * xv[j][2] + xv[j][3] * xv[j][3]; xv[j] = xv[j] * gvj; }
            u32x4 lo, hi;
            lo.x = pk2(xv[0][0], xv[0][1]); lo.y = pk2(xv[0][2], xv[0][3]); lo.z = pk2(xv[1][0], xv[1][1]); lo.w = pk2(xv[1][2], xv[1][3]);
            hi.x = pk2(xv[2][0], xv[2][1]); hi.y = pk2(xv[2][2], xv[2][3]); hi.z = pk2(xv[3][0], xv[3][1]); hi.w = pk2(xv[3][2], xv[3][3]);
            *(GAS u32x2*)(hr + c0) = (u32x2){lo.x, lo.y}; *(GAS u32x2*)(hr + c0 + 16) = (u32x2){lo.z, lo.w};
            *(GAS u32x2*)(hr + c0 + 32) = (u32x2){hi.x, hi.y}; *(GAS u32x2*)(hr + c0 + 48) = (u32x2){hi.z, hi.w};
            const LAS unsigned char* wb = wxl + fr * 2064 + c0 * 2;
            const u32x2 b0 = *(const LAS u32x2*)(wb), b1 = *(const LAS u32x2*)(wb + 32), b2 = *(const LAS u32x2*)(wb + 64), b3 = *(const LAS u32x2*)(wb + 96);
            const bf16x8 blo = __builtin_bit_cast(bf16x8, (u32x4){b0.x, b0.y, b1.x, b1.y}), bhi = __builtin_bit_cast(bf16x8, (u32x4){b2.x, b2.y, b3.x, b3.y});
            acc = MFMA16(__builtin_bit_cast(bf16x8, lo), blo, acc); acc = MFMA16(__builtin_bit_cast(bf16x8, hi), bhi, acc);
        }
    }
    ss += __shfl_xor(ss, 16); ss += __shfl_xor(ss, 32);
    if (fq == 0) ((GAS float*)(ws + WS_RROW))[row] = rsqrtf(ss * (1.f / 1024.f) + 1e-6f);
    GAS float* px = (GAS float*)(ws + WS_PX);
#pragma unroll
    for (int r = 0; r < 4; ++r) px[(size_t)(rowb + w * 16 + fq * 4 + r) * 16 + fr] = acc[r];
    __syncthreads();
}

__device__ __attribute__((noinline)) void gmlp_tile(LAS unsigned char* lds, GAS unsigned char* ws, const GAS float* ln_w_l, const GAS float* a_bs_l, int l, int R0, int tid) {
    GAS bf16_t* P = (GAS bf16_t*)(ws + WS_P);
    LAS bf16_t* vcT = (LAS bf16_t*)lds;
    const int lane = tid & 63, w = tid >> 6, fr = lane & 15, fq = lane >> 4;
    {
        const int t = tid >> 2, gq = tid & 3;
        const GAS bf16_t* vp = P + (size_t)(R0 + t) * LDP + PA_V + gq * 8;
        float xv[64];
#pragma unroll
        for (int i = 0; i < 8; ++i) { const u32x4 q = *(const GAS u32x4*)(vp + i * 32);
            xv[i * 8 + 0] = bflo(q.x); xv[i * 8 + 1] = bfhi(q.x); xv[i * 8 + 2] = bflo(q.y); xv[i * 8 + 3] = bfhi(q.y);
            xv[i * 8 + 4] = bflo(q.z); xv[i * 8 + 5] = bfhi(q.z); xv[i * 8 + 6] = bflo(q.w); xv[i * 8 + 7] = bfhi(q.w); }
        float s = 0.f;
#pragma unroll
        for (int i = 0; i < 64; ++i) s += xv[i];
        s += __shfl_xor(s, 1); s += __shfl_xor(s, 2);
        const float mean = s * (1.f / 256.f);
        float q2 = 0.f;
#pragma unroll
        for (int i = 0; i < 64; ++i) { const float d = xv[i] - mean; q2 += d * d; }
        q2 += __shfl_xor(q2, 1); q2 += __shfl_xor(q2, 2);
        const float rs = rsqrtf(q2 * (1.f / 256.f) + 1e-5f);
#pragma unroll
        for (int i = 0; i < 64; ++i) { const int ch = ((i >> 3) * 4 + gq) * 8 + (i & 7); vcT[ch * 136 + t] = f2bf((xv[i] - mean) * rs * ln_w_l[ch]); }
    }
    __syncthreads();
    const int g = w >> 1, ih = w & 1;
    f32x4 acc[4][4];
#pragma unroll
    for (int mi = 0; mi < 4; ++mi)
#pragma unroll
        for (int ni = 0; ni < 4; ++ni) acc[mi][ni] = (f32x4){0.f, 0.f, 0.f, 0.f};
    const GAS bf16_t* aw = (const GAS bf16_t*)(ws + WS_AWS) + (size_t)(l * 4 + g) * 128 * 128;
#pragma unroll
    for (int ks = 0; ks < 4; ++ks) {
        bf16x8 af[4], bf[4];
#pragma unroll
        for (int mi = 0; mi < 4; ++mi) af[mi] = *(const GAS bf16x8*)(aw + (size_t)(ih * 64 + mi * 16 + fr) * 128 + ks * 32 + fq * 8);
#pragma unroll
        for (int ni = 0; ni < 4; ++ni) bf[ni] = *(const LAS bf16x8*)(vcT + (g * 64 + (ni >> 1) * 32 + (fr >> 2) * 8 + (ni & 1) * 4 + (fr & 3)) * 136 + ks * 32 + fq * 8);
#pragma unroll
        for (int mi = 0; mi < 4; ++mi)
#pragma unroll
            for (int ni = 0; ni < 4; ++ni) acc[mi][ni] = MFMA16(bf[ni], af[mi], acc[mi][ni]);
    }
#pragma unroll
    for (int mi = 0; mi < 4; ++mi) {
        const int tok = ih * 64 + mi * 16 + fr;
        const float bs = a_bs_l[g * 128 + tok];
        GAS bf16_t* pr = P + (size_t)(R0 + tok) * LDP;
#pragma unroll
        for (int a2 = 0; a2 < 2; ++a2) {
            const int c0 = g * 64 + a2 * 32 + fq * 8;
            const u32x4 uu = *(const GAS u32x4*)(pr + PA_U + c0), zz = *(const GAS u32x4*)(pr + PA_Z + c0);
            const f32x4 s0 = acc[mi][2 * a2], s1 = acc[mi][2 * a2 + 1];
            u32x4 o;
            o.x = pk2(bflo(uu.x) * (s0[0] + bs) * silu_f(bflo(zz.x)), bfhi(uu.x) * (s0[1] + bs) * silu_f(bfhi(zz.x)));
            o.y = pk2(bflo(uu.y) * (s0[2] + bs) * silu_f(bflo(zz.y)), bfhi(uu.y) * (s0[3] + bs) * silu_f(bfhi(zz.y)));
            o.z = pk2(bflo(uu.z) * (s1[0] + bs) * silu_f(bflo(zz.z)), bfhi(uu.z) * (s1[1] + bs) * silu_f(bfhi(zz.z)));
            o.w = pk2(bflo(uu.w) * (s1[2] + bs) * silu_f(bflo(zz.w)), bfhi(uu.w) * (s1[3] + bs) * silu_f(bfhi(zz.w)));
            *(GAS u32x4*)(pr + PA_U + c0) = o;
        }
    }
    __syncthreads();
}

__device__ __forceinline__ void attn_tile(LAS unsigned char* lds, GAS unsigned char* ws, const GAS float* sw, int b, int h, int qrow0, int nkt, float lam, float osc, int w) {
    GAS bf16_t* P = (GAS bf16_t*)(ws + WS_P);
    const GAS bf16_t* VT = (const GAS bf16_t*)(ws + WS_VT);
    const int lane = lane_id_v(), tid = w * 64 + lane, sub = w >> 2, qw = w & 3, l31 = lane & 31, hi = lane >> 5;
    const int qrow = qrow0 + qw * 32 + l31;
    bf16x8 qf[4];
    { const GAS bf16_t* qp = P + (size_t)qrow * LDP + PB_Q + (2 * h + sub) * 64 + hi * 8;
#pragma unroll
      for (int ks = 0; ks < 4; ++ks) qf[ks] = *(const GAS bf16x8*)(qp + ks * 16); }
    f32x16 O[4];
    float zf; asm volatile("v_mov_b32 %0, 0" : "=v"(zf));
#pragma unroll
    for (int d = 0; d < 4; ++d)
#pragma unroll
        for (int r = 0; r < 16; ++r) O[d][r] = zf;
    float m = -INFINITY, lsum = 0.f;
    const float cs = 0.125f * 1.44269504088896f;
    u32x4 kr[2][2], vr[2][2];
    const GAS bf16_t* vbase = VT + (size_t)(b * 4 + h) * 128 * 2304;
#define ATT_LOAD(kt, S_) do { const int krow0_ = ((kt) < 4) ? (NLAT + b * 256 + (kt) * 64) : (b * 2048 + ((kt) - 4) * 64); \
        _Pragma("unroll") for (int i_ = 0; i_ < 2; ++i_) { const int idx_ = tid + 512 * i_; \
            kr[S_][i_] = *(const GAS u32x4*)(P + (size_t)(krow0_ + (idx_ >> 4)) * LDP + PB_K + 2 * h * 64 + (idx_ & 15) * 8); \
            vr[S_][i_] = *(const GAS u32x4*)(vbase + (size_t)(idx_ >> 3) * 2304 + (kt) * 64 + (idx_ & 7) * 8); } } while (0)
#define ATT_STORE(s, S_) do { _Pragma("unroll") for (int i_ = 0; i_ < 2; ++i_) { const int idx_ = tid + 512 * i_; const int key_ = idx_ >> 4, part_ = idx_ & 15; \
            *(LAS u32x4*)(lds + (s) * 36864 + (((part_ >> 3) * 64 + key_) * 72 + (part_ & 7) * 8) * 2) = kr[S_][i_]; \
            *(LAS u32x4*)(lds + (s) * 36864 + 18432 + ((idx_ >> 3) * 72 + (idx_ & 7) * 8) * 2) = vr[S_][i_]; } } while (0)
#define KFR(rowo, ks_) (*(const LAS bf16x8*)(kb_ + (((rowo) + l31) * 72 + (ks_) * 16 + hi * 8) * 2))
#define VFR(d_, g_) (*(const LAS bf16x8*)(vb_ + (((d_) * 32 + l31) * 72 + (g_) * 16 + hi * 8) * 2))
#define ATT_BODY(KT_, LSET_, SSET_) do { const int s = (KT_) & 1; \
        if ((KT_) + 2 < nkt) ATT_LOAD((KT_) + 2, LSET_); \
        f32x16 S0, S1; \
        const LAS unsigned char* kb_ = lds + s * 36864 + sub * (64 * 72 * 2); \
        const LAS unsigned char* vb_ = lds + s * 36864 + 18432; \
        bf16x8 a0 = KFR(0, 0), a1 = KFR(32, 0); \
_Pragma("unroll") \
        for (int ks = 0; ks < 4; ++ks) { \
            bf16x8 n0 = a0, n1 = a1; \
            if (ks < 3) { n0 = KFR(0, ks + 1); n1 = KFR(32, ks + 1); } \
            __builtin_amdgcn_sched_barrier(0); \
            if (ks == 0) { const f32x16 z = {0.f, 0.f, 0.f, 0.f, 0.f, 0.f, 0.f, 0.f, 0.f, 0.f, 0.f, 0.f, 0.f, 0.f, 0.f, 0.f}; S0 = MFMA32(a0, qf[0], z); S1 = MFMA32(a1, qf[0], z); } \
            else { S0 = MFMA32(a0, qf[ks], S0); S1 = MFMA32(a1, qf[ks], S1); } \
            __builtin_amdgcn_sched_barrier(0); \
            a0 = n0; a1 = n1; \
        } \
        bf16x8 vfr[4];    \
_Pragma("unroll") \
        for (int d = 0; d < 4; ++d) vfr[d] = VFR(d, 0); \
        __builtin_amdgcn_sched_barrier(0); \
        float mx = S0[0]; \
_Pragma("unroll") \
        for (int r = 1; r < 16; ++r) mx = fmaxf(mx, S0[r]); \
_Pragma("unroll") \
        for (int r = 0; r < 16; ++r) mx = fmaxf(mx, S1[r]); \
        mx = fmaxf(mx, shfl_x32(mx, lane)); \
        if (__builtin_amdgcn_ballot_w64((mx - m) * cs > 8.f) != 0ull) { \
            const float mn = fmaxf(m, mx); \
            const float alpha = __builtin_amdgcn_exp2f((m - mn) * cs); \
            m = mn; \
            lsum *= alpha; \
_Pragma("unroll") \
            for (int d = 0; d < 4; ++d) \
_Pragma("unroll") \
                for (int r = 0; r < 16; ++r) O[d][r] *= alpha; \
        } \
        const float mc = m * cs; \
        float rs = 0.f; \
        bf16x8 pk[2][2]; \
_Pragma("unroll") \
        for (int s2 = 0; s2 < 2; ++s2) { \
            u32x4 t0, t1; \
_Pragma("unroll") \
            for (int j = 0; j < 4; ++j) { \
                const float e0 = __builtin_amdgcn_exp2f(S0[8 * s2 + 2 * j] * cs - mc), e1 = __builtin_amdgcn_exp2f(S0[8 * s2 + 2 * j + 1] * cs - mc); \
                const float f0 = __builtin_amdgcn_exp2f(S1[8 * s2 + 2 * j] * cs - mc), f1 = __builtin_amdgcn_exp2f(S1[8 * s2 + 2 * j + 1] * cs - mc); \
                rs += (e0 + e1) + (f0 + f1); \
                t0[j] = pk2(e0, e1); t1[j] = pk2(f0, f1); \
            } \
            pk[0][s2] = __builtin_bit_cast(bf16x8, t0); pk[1][s2] = __builtin_bit_cast(bf16x8, t1); \
        } \
        lsum += rs; \
        __builtin_amdgcn_sched_barrier(0); \
_Pragma("unroll") \
        for (int g = 0; g < 4; ++g) {    \
            bf16x8 nfr[4]; \
_Pragma("unroll") \
            for (int d = 0; d < 4; ++d) nfr[d] = (g < 3) ? VFR(d, g + 1) : vfr[d]; \
            __builtin_amdgcn_sched_barrier(0); \
_Pragma("unroll") \
            for (int d = 0; d < 4; ++d) O[d] = MFMA32(vfr[d], pk[g >> 1][g & 1], O[d]); \
            __builtin_amdgcn_sched_barrier(0); \
_Pragma("unroll") \
            for (int d = 0; d < 4; ++d) vfr[d] = nfr[d]; \
        } \
        if ((KT_) + 1 < nkt) ATT_STORE(s ^ 1, SSET_); \
        __syncthreads(); } while (0)
    ATT_LOAD(0, 0); ATT_STORE(0, 0);
    if (nkt > 1) ATT_LOAD(1, 1);
    __syncthreads();
    if (sub == 1) __builtin_amdgcn_s_setprio(1);
    for (int kt = 0; kt < nkt; kt += 2) {
        ATT_BODY(kt, 0, 1);
        ATT_BODY(kt + 1, 1, 0);
    }
#undef ATT_BODY
    __builtin_amdgcn_s_setprio(0);
#undef KFR
#undef VFR
#undef ATT_LOAD
#undef ATT_STORE
    lsum += shfl_x32(lsum, lane);
    const float inv = 1.f / lsum;
    LAS float* O2 = (LAS float*)lds;
    if (sub == 1) {
#pragma unroll
        for (int d = 0; d < 4; ++d)
#pragma unroll
            for (int rg = 0; rg < 4; ++rg) { f32x4 v = {O[d][4 * rg] * inv, O[d][4 * rg + 1] * inv, O[d][4 * rg + 2] * inv, O[d][4 * rg + 3] * inv};
                *(LAS f32x4*)(O2 + (qw * 32 + l31) * 132 + d * 32 + 8 * rg + 4 * hi) = v; }
    }
    __syncthreads();
    if (sub == 0) {
        float ss = 0.f;
#pragma unroll
        for (int d = 0; d < 4; ++d)
#pragma unroll
            for (int rg = 0; rg < 4; ++rg) { const f32x4 o2 = *(const LAS f32x4*)(O2 + (qw * 32 + l31) * 132 + d * 32 + 8 * rg + 4 * hi);
#pragma unroll
                for (int e = 0; e < 4; ++e) { const float o = O[d][4 * rg + e] * inv - lam * o2[e]; O[d][4 * rg + e] = o; ss += o * o; } }
        ss += shfl_x32(ss, lane);
        const float rr = rsqrtf(ss * (1.f / 128.f) + 1e-6f) * osc;
        GAS bf16_t* zp0 = P + (size_t)qrow * LDP + PB_Z + h * 128;
#pragma unroll
        for (int d = 0; d < 4; ++d)
#pragma unroll
            for (int rg = 0; rg < 4; ++rg) { const int dv0 = d * 32 + 8 * rg + 4 * hi;
                const f32x4 w4 = *(const GAS f32x4*)(sw + dv0); const u32x2 zz = *(const GAS u32x2*)(zp0 + dv0);
                const float y0 = O[d][4 * rg + 0] * rr * w4[0] * silu_f(bflo(zz.x)), y1 = O[d][4 * rg + 1] * rr * w4[1] * silu_f(bfhi(zz.x));
                const float y2 = O[d][4 * rg + 2] * rr * w4[2] * silu_f(bflo(zz.y)), y3 = O[d][4 * rg + 3] * rr * w4[3] * silu_f(bfhi(zz.y));
                u32x2 o; o.x = pk2(y0, y1); o.y = pk2(y2, y3); *(GAS u32x2*)(zp0 + dv0) = o; }
    }
    __syncthreads();
}

template <int DD>
__device__ __forceinline__ void gdn_solve(const LAS float* Lb, const LAS float* src, const LAS float* fac, int lane, int part, GAS unsigned char* rec) {
    float x[64];
#pragma unroll
    for (int p = 0; p < 64; ++p) {
        const int tn = DD ? 63 - p : p;
        const float rhs = src[tn * 68 + lane] * fac[p];
        f32x2 sa = {0.f, 0.f}, sb = {0.f, 0.f};
#pragma unroll
        for (int q = 0; q < p; q += 4) {
            f32x4 lv;
            if (DD == 0) lv = *(const LAS f32x4*)(Lb + p * 68 + q);
            else { const f32x4 t = *(const LAS f32x4*)(Lb + (63 - p) * 68 + (60 - q)); lv = (f32x4){t[3], t[2], t[1], t[0]}; }
            if (q + 1 < p) sa += (f32x2){lv[0], lv[1]} * (f32x2){x[q], x[q + 1]}; else sa[0] += lv[0] * x[q];
            if (q + 3 < p) sb += (f32x2){lv[2], lv[3]} * (f32x2){x[q + 2], x[q + 3]}; else if (q + 2 < p) sb[0] += lv[2] * x[q + 2];
        }
        x[p] = rhs - ((sa[0] + sa[1]) + (sb[0] + sb[1]));
    }
    if (part == 0) {
        GAS bf16_t* ut = (GAS bf16_t*)(rec + 32768) + lane * 64;
#pragma unroll
        for (int i = 0; i < 8; ++i) { u32x4 w; w.x = pk2(x[8 * i], x[8 * i + 1]); w.y = pk2(x[8 * i + 2], x[8 * i + 3]); w.z = pk2(x[8 * i + 4], x[8 * i + 5]); w.w = pk2(x[8 * i + 6], x[8 * i + 7]); *(GAS u32x4*)(ut + 8 * i) = w; }
    } else {
        GAS bf16_t* wn = (GAS bf16_t*)rec + pi64(lane);
#pragma unroll
        for (int p = 0; p < 64; ++p) wn[p * 64] = f2bf(-x[p]);
    }
}

__device__ __attribute__((noinline)) void gdn_prep_tile(LAS unsigned char* lds, GAS unsigned char* ws, const GAS float* conv_w_l, const GAS float* a_log_l, const GAS float* dt_bias_l, int l, int b, int seg, int c, int hp, int tid) {
    const GAS bf16_t* P = (const GAS bf16_t*)(ws + WS_P);
    const int hh = tid >> 8, ltid = tid & 255, lane = tid & 63, wv = (tid >> 6) & 3, fr = lane & 15, fq = lane >> 4;
    const int h = hp * 2 + hh;
    LAS unsigned char* hb = lds + hh * 71680;
    LAS float* qf = (LAS float*)hb; LAS float* kf = (LAS float*)(hb + 17408); LAS float* vf = (LAS float*)(hb + 34816); LAS float* Lb = (LAS float*)(hb + 52224);
    LAS float* beta = (LAS float*)(hb + 69632); LAS float* gg = (LAS float*)(hb + 70144); LAS float* gc = (LAS float*)(hb + 70656); LAS float* fw = (LAS float*)(hb + 71168);
    const int seglen = seg ? SEQL : CTXL;
    const int rowbase = seg ? b * SEQL : NLAT + b * CTXL;
    const int mrow = seg ? b : 32;
    {
        const int ch2 = ltid & 31, tg = ltid >> 5;
#pragma unroll
        for (int part = 0; part < 3; ++part) {
            const int col = PC_Q + part * 256 + h * 64 + 2 * ch2;
            const GAS float* cw = conv_w_l + part * 256 + h * 64 + 2 * ch2;
            float w0[5], w1[5];
#pragma unroll
            for (int j = 0; j < 5; ++j) { const f32x2 t = *(const GAS f32x2*)(cw + j * 768); w0[j] = t[0]; w1[j] = t[1]; }
            float x0[12], x1[12];
#pragma unroll
            for (int i = 0; i < 12; ++i) { const int tt = c * 64 + tg * 8 - 2 + i;
                unsigned u = 0u; if (tt >= 0 && tt < seglen) u = *(const GAS unsigned*)(P + (size_t)(rowbase + tt) * LDP + col);
                x0[i] = bflo(u); x1[i] = bfhi(u); }
            LAS float* dst = part == 0 ? qf : (part == 1 ? kf : vf);
#pragma unroll
            for (int o = 0; o < 8; ++o) { float s0 = 0.f, s1 = 0.f;
#pragma unroll
                for (int j = 0; j < 5; ++j) { s0 += x0[o + j] * w0[j]; s1 += x1[o + j] * w1[j]; }
                *(LAS f32x2*)(dst + (tg * 8 + o) * 68 + 2 * ch2) = (f32x2){silu_f(s0), silu_f(s1)}; }
        }
    }
    __syncthreads();
    {
        const int rr = ltid >> 1, half = ltid & 1;
        LAS float* rp = (rr < 64 ? qf + rr * 68 : kf + (rr - 64) * 68) + half * 32;
        float v[32]; float ss = 0.f;
#pragma unroll
        for (int i = 0; i < 8; ++i) { const f32x4 t = *(const LAS f32x4*)(rp + 4 * i); v[4 * i] = t[0]; v[4 * i + 1] = t[1]; v[4 * i + 2] = t[2]; v[4 * i + 3] = t[3]; ss += t[0] * t[0] + t[1] * t[1] + t[2] * t[2] + t[3] * t[3]; }
        ss += __shfl_xor(ss, 1);
        const float sc = rsqrtf(ss + 1e-6f);
#pragma unroll
        for (int i = 0; i < 8; ++i) *(LAS f32x4*)(rp + 4 * i) = (f32x4){v[4 * i] * sc, v[4 * i + 1] * sc, v[4 * i + 2] * sc, v[4 * i + 3] * sc};
        if (ltid < 128) {
            const int dd = ltid >> 6, p = ltid & 63, tn = dd ? 63 - p : p;
            const int row = rowbase + c * 64 + tn;
            const float rw = ((const GAS float*)(ws + WS_RROW))[row];
            const GAS float* px = (const GAS float*)(ws + WS_PX) + (size_t)row * 16;
            const GAS float* sw = (const GAS float*)(ws + WS_SW) + (size_t)l * 33 * DIN + (size_t)mrow * DIN + 3840;
            const float braw = px[dd * 4 + h] * rw + sw[dd * 4 + h];
            const float araw = px[8 + dd * 4 + h] * rw + sw[8 + dd * 4 + h];
            const float xs = araw + dt_bias_l[dd * 4 + h];
            const float sp = xs > 20.f ? xs : log1pf(expf(xs));
            beta[dd * 64 + p] = 1.f / (1.f + expf(-braw));
            gg[dd * 64 + p] = -expf(a_log_l[dd * 4 + h]) * sp;
        }
    }
    __syncthreads();
    if (wv == 0) {
#pragma unroll
        for (int dd = 0; dd < 2; ++dd) {
            float v = gg[dd * 64 + lane];
#pragma unroll
            for (int o = 1; o < 64; o <<= 1) { const float t = __shfl_up(v, o); if (lane >= o) v += t; }
            gc[dd * 64 + lane] = v;
            fw[dd * 64 + lane] = beta[dd * 64 + lane] * fexp(v);
            gg[dd * 64 + lane] = fexp(__shfl(v, 63) - v);
        }
    }
    __syncthreads();
    const int st0 = seg ? 4 + c : c, st1 = seg ? 4 + (31 - c) : 3 - c;
    GAS unsigned char* rec0 = ws + WS_H + ((size_t)((b * 4 + h) * 2 + 0) * 36 + st0) * GREC;
    GAS unsigned char* rec1 = ws + WS_H + ((size_t)((b * 4 + h) * 2 + 1) * 36 + st1) * GREC;
    {
        const int mt = wv;
        bf16x8 ak[2], aq[2];
#pragma unroll
        for (int ks = 0; ks < 2; ++ks) {
            const LAS float* kp = kf + (mt * 16 + fr) * 68 + ks * 32 + fq * 8; const LAS float* qp = qf + (mt * 16 + fr) * 68 + ks * 32 + fq * 8;
            ak[ks] = pack8(*(const LAS f32x4*)kp, *(const LAS f32x4*)(kp + 4)); aq[ks] = pack8(*(const LAS f32x4*)qp, *(const LAS f32x4*)(qp + 4));
        }
#pragma unroll
        for (int nt = 0; nt < 4; ++nt) {
            bf16x8 bk[2];
#pragma unroll
            for (int ks = 0; ks < 2; ++ks) { const LAS float* kp = kf + (nt * 16 + fr) * 68 + ks * 32 + fq * 8; bk[ks] = pack8(*(const LAS f32x4*)kp, *(const LAS f32x4*)(kp + 4)); }
            f32x4 KK = {0.f, 0.f, 0.f, 0.f}, QK = {0.f, 0.f, 0.f, 0.f};
            KK = MFMA16(ak[0], bk[0], KK); KK = MFMA16(ak[1], bk[1], KK);
            QK = MFMA16(aq[0], bk[0], QK); QK = MFMA16(aq[1], bk[1], QK);
            const int j = nt * 16 + fr;
            const float g0j = gc[j], g1j = gc[64 + 63 - j];
#pragma unroll
            for (int r = 0; r < 4; ++r) {
                const int i = mt * 16 + fq * 4 + r;
                const float g0i = gc[i], g1i = gc[64 + 63 - i];
                if (i > j) Lb[i * 68 + j] = beta[i] * KK[r] * fexp(g0i - g0j);
                else if (i < j) Lb[i * 68 + j] = beta[64 + 63 - i] * KK[r] * fexp(g1i - g1j);
                const float qv = QK[r] * 0.125f;
                const float a0 = (i >= j) ? qv * fexp(g0i - g0j) : 0.f;
                const float a1 = (i <= j) ? qv * fexp(g1i - g1j) : 0.f;
                ((GAS bf16_t*)(rec0 + 16384))[i * 64 + pi64(j)] = f2bf(a0);
                ((GAS bf16_t*)(rec1 + 16384))[(63 - i) * 64 + pi64(63 - j)] = f2bf(a1);
            }
        }
#pragma unroll
        for (int it = 0; it < 4; ++it) {
            const int idx = ltid + 256 * it, dd = idx >> 9, rem = idx & 511, rowi = rem >> 3, blk = rem & 7, ks = blk >> 2, q4 = blk & 3;
            GAS unsigned char* rec = dd ? rec1 : rec0;
            {
                const int tn = dd ? 63 - rowi : rowi; const float f = 0.125f * fexp(gc[dd * 64 + rowi]);
                const f32x4 v0 = *(const LAS f32x4*)(qf + tn * 68 + 32 * ks + 4 * q4), v1 = *(const LAS f32x4*)(qf + tn * 68 + 32 * ks + 16 + 4 * q4);
                *(GAS bf16x8*)((GAS bf16_t*)(rec + 8192) + rowi * 64 + blk * 8) = pack8(v0 * f, v1 * f);
            }
            {
                const f32x4 ek0 = *(const LAS f32x4*)(gg + dd * 64 + 32 * ks + 4 * q4), ek1 = *(const LAS f32x4*)(gg + dd * 64 + 32 * ks + 16 + 4 * q4);
                f32x4 v0, v1;
#pragma unroll
                for (int e = 0; e < 4; ++e) { const int p0 = 32 * ks + 4 * q4 + e, p1 = p0 + 16; const int t0 = dd ? 63 - p0 : p0, t1 = dd ? 63 - p1 : p1;
                    v0[e] = kf[t0 * 68 + rowi] * ek0[e]; v1[e] = kf[t1 * 68 + rowi] * ek1[e]; }
                *(GAS bf16x8*)((GAS bf16_t*)(rec + 24576) + rowi * 64 + blk * 8) = pack8(v0, v1);
            }
        }
        if (ltid < 2) { const int dd = ltid; ((GAS float*)(ws + WS_EG))[((b * 4 + h) * 2 + dd) * 36 + (dd ? st1 : st0)] = fexp(gc[dd * 64 + 63]); }
    }
    __syncthreads();
    {
        const int dd = wv >> 1, part = wv & 1;
        const LAS float* src = part ? kf : vf;
        const LAS float* fac = part ? fw + dd * 64 : beta + dd * 64;
        if (dd == 0) gdn_solve<0>(Lb, src, fac, lane, part, rec0); else gdn_solve<1>(Lb, src, fac, lane, part, rec1);
    }
    __syncthreads();
}

__device__ __attribute__((noinline)) void gdn_scan_tile(LAS unsigned char* lds, GAS unsigned char* ws, int t, int tid) {
    GAS bf16_t* P = (GAS bf16_t*)(ws + WS_P);
    const int lane = tid & 63, w = tid >> 6, sq = w >> 2, sl = w & 3, fr = lane & 15, fq = lane >> 4, lt = tid & 255;
    const int sid = 2 * t + sq, dd = sid & 1, h = (sid >> 1) & 3, b = sid >> 3;
    const GAS unsigned GAS char* rec0 = ws + WS_H + (size_t)sid * 36 * GREC;
    const GAS float* EG = (const GAS float*)(ws + WS_EG) + sid * 36;
    f32x4 S[4];
#pragma unroll
    for (int i = 0; i < 4; ++i) S[i] = (f32x4){0.f, 0.f, 0.f, 0.f};
    u32x4 pre[8]; u32x2 ut[4], utn[4]; float eg, egn;
#define SC_LOAD(st) do { const GAS unsigned GAS char* rec_ = rec0 + (size_t)(st) * GREC; \
        _Pragma("unroll") for (int i_ = 0; i_ < 8; ++i_) pre[i_] = *(const GAS u32x4*)(rec_ + (size_t)(lt + 256 * i_) * 16); \
        _Pragma("unroll") for (int m_ = 0; m_ < 4; ++m_) utn[m_] = *(const GAS u32x2*)(rec_ + 32768 + ((sl * 16 + fr) * 64 + m_ * 16 + fq * 4) * 2); \
        egn = EG[(st)]; } while (0)
#define SC_STORE(pp) do { _Pragma("unroll") for (int i_ = 0; i_ < 8; ++i_) { const int idx_ = lt + 256 * i_; \
        *(LAS u32x4*)(lds + ((pp) * 2 + sq) * 36864 + (idx_ >> 9) * 9216 + ((idx_ >> 3) & 63) * 144 + (idx_ & 7) * 16) = pre[i_]; } \
        _Pragma("unroll") for (int m_ = 0; m_ < 4; ++m_) ut[m_] = utn[m_]; eg = egn; } while (0)
    SC_LOAD(0); SC_STORE(0); __syncthreads();
    for (int st = 0; st < 36; ++st) {
        if (st + 1 < 36) SC_LOAD(st + 1);
        const LAS unsigned char* B = lds + ((st & 1) * 2 + sq) * 36864;
#define SC_FR(arr, mt, ks) (*(const LAS bf16x8*)(B + (arr) * 9216 + ((mt) * 16 + fr) * 144 + ((ks) * 32 + fq * 8) * 2))
        bf16x8 Sb[2], Vb[2];
        Sb[0] = pack8(S[0], S[1]); Sb[1] = pack8(S[2], S[3]);
        f32x4 av[4], ao[4];
#pragma unroll
        for (int mt = 0; mt < 4; ++mt) { av[mt] = (f32x4){bflo(ut[mt].x), bfhi(ut[mt].x), bflo(ut[mt].y), bfhi(ut[mt].y)};
            av[mt] = MFMA16(SC_FR(0, mt, 0), Sb[0], av[mt]); av[mt] = MFMA16(SC_FR(0, mt, 1), Sb[1], av[mt]); }
        Vb[0] = pack8(av[0], av[1]); Vb[1] = pack8(av[2], av[3]);
#pragma unroll
        for (int mt = 0; mt < 4; ++mt) { ao[mt] = (f32x4){0.f, 0.f, 0.f, 0.f};
            ao[mt] = MFMA16(SC_FR(1, mt, 0), Sb[0], ao[mt]); ao[mt] = MFMA16(SC_FR(1, mt, 1), Sb[1], ao[mt]);
            ao[mt] = MFMA16(SC_FR(2, mt, 0), Vb[0], ao[mt]); ao[mt] = MFMA16(SC_FR(2, mt, 1), Vb[1], ao[mt]); }
#pragma unroll
        for (int mt = 0; mt < 4; ++mt) { f32x4 as = S[mt] * eg;
            as = MFMA16(SC_FR(3, mt, 0), Vb[0], as); as = MFMA16(SC_FR(3, mt, 1), Vb[1], as); S[mt] = as; }
#undef SC_FR
        {
            const int seg = st >= 4, ci = seg ? st - 4 : st;
            const int cn = dd ? (seg ? 31 - ci : 3 - ci) : ci;
            const int rowbase = (seg ? b * SEQL : NLAT + b * CTXL) + cn * 64;
            GAS bf16_t* op = P + (dd ? PC_K : PC_Q) + h * 64 + sl * 16 + fr;
#pragma unroll
            for (int mt = 0; mt < 4; ++mt)
#pragma unroll
                for (int r = 0; r < 4; ++r) { const int p = mt * 16 + fq * 4 + r, tn = dd ? 63 - p : p; op[(size_t)(rowbase + tn) * LDP] = f2bf(ao[mt][r]); }
        }
        if (st + 1 < 36) SC_STORE((st + 1) & 1);
        __syncthreads();
    }
#undef SC_LOAD
#undef SC_STORE
}


__device__ __forceinline__ void gemm_in_phase(LAS unsigned char* lds, GAS unsigned char* ws, int l, int G, int bx, int wid) {
    GAS float* sWl = (GAS float*)(ws + WS_SW) + (size_t)l * 33 * DIN;
    pg8::Gemm g{(const GAS bf16_t*)(ws + WS_H), (const GAS bf16_t*)(ws + WS_WIN) + (size_t)l * 3840 * 1024, NT, NPJ, 1024, 1024, 0};
    pg8::StaticOrder S; if (l == 1) { S.init(NLAT, NPJ, G, bx); S.nextra = 32 * 7; } else S.init(NT, NPJ, G, bx);
    EpiP E{(GAS bf16_t*)(ws + WS_P), (GAS bf16_t*)(ws + WS_VT), (const GAS float*)(ws + WS_RROW), sWl, (const GAS f32x2*)(ws + WS_ROPE)};
    pg8::gemm_phase<EpiP>(lds, g, S, E, wid);
}
__device__ __forceinline__ void gemm_out_phase(LAS unsigned char* lds, GAS unsigned char* ws, int l, int G, int bx, const GAS float* xlat, const GAS float* xctx, GAS float* out, int wid) {
    const GAS float* modl = (const GAS float*)(ws + WS_MOD) + (size_t)l * 33 * 3072;
    const int M = l ? NLAT : NT;
    pg8::Gemm g{(const GAS bf16_t*)(ws + WS_P), (const GAS bf16_t*)(ws + WS_WOUT) + (size_t)l * 1024 * 1024, M, 1024, 1024, LDP, 1};
    pg8::StaticOrder S; S.init(M, 1024, G, bx);
    EpiRes E{xlat, xctx, out, (GAS float*)(ws + WS_XC1), modl + 2048};
    pg8::gemm_phase<EpiRes>(lds, g, S, E, wid);
}


__device__ __attribute__((noinline)) float compute_lam(const GAS float* lf, float lam_init, int tid) {
    const int ln = tid & 63;
    float p1 = lf[ln] * lf[64 + ln], p2 = lf[128 + ln] * lf[192 + ln];
#pragma unroll
    for (int o = 32; o >= 1; o >>= 1) { p1 += __shfl_xor(p1, o); p2 += __shfl_xor(p2, o); }
    return expf(p1) - expf(p2) + lam_init;
}
__device__ __attribute__((noinline)) void gdn_finish_phase(GAS unsigned char* ws, const GAS float* cw, int nrows, int vb, int G, int tid) {
    GAS bf16_t* P = (GAS bf16_t*)(ws + WS_P);
    const size_t total = (size_t)nrows * 32, stride = (size_t)G * NTHREADS;
    for (size_t idx0 = (size_t)vb * NTHREADS + tid; idx0 < total; idx0 += 3 * stride) {
        u32x4 of[3], ob[3], zz[3];
#pragma unroll
        for (int q = 0; q < 3; ++q) { const size_t idx = idx0 + q * stride;
            if (idx < total) { const int row = (int)(idx >> 5), hg = (int)(idx & 31);
                const GAS bf16_t* pr = P + (size_t)row * LDP + hg * 8;
                of[q] = *(const GAS u32x4*)(pr + PC_Q); ob[q] = *(const GAS u32x4*)(pr + PC_K); zz[q] = *(const GAS u32x4*)(pr + PC_Z); } }
#pragma unroll
        for (int q = 0; q < 3; ++q) { const size_t idx = idx0 + q * stride;
            if (idx < total) { const int row = (int)(idx >> 5), hg = (int)(idx & 31), part = hg & 7;
                GAS bf16_t* pr = P + (size_t)row * LDP + hg * 8;
                float o[8];
                o[0] = bflo(of[q].x) + bflo(ob[q].x); o[1] = bfhi(of[q].x) + bfhi(ob[q].x); o[2] = bflo(of[q].y) + bflo(ob[q].y); o[3] = bfhi(of[q].y) + bfhi(ob[q].y);
                o[4] = bflo(of[q].z) + bflo(ob[q].z); o[5] = bfhi(of[q].z) + bfhi(ob[q].z); o[6] = bflo(of[q].w) + bflo(ob[q].w); o[7] = bfhi(of[q].w) + bfhi(ob[q].w);
                float ss = 0.f;
#pragma unroll
                for (int e = 0; e < 8; ++e) ss += o[e] * o[e];
                ss += __shfl_xor(ss, 1); ss += __shfl_xor(ss, 2); ss += __shfl_xor(ss, 4);
                const float rr = rsqrtf(ss * (1.f / 64.f) + 1e-6f);
                const f32x4 w0 = *(const GAS f32x4*)(cw + part * 8), w1 = *(const GAS f32x4*)(cw + part * 8 + 4);
                u32x4 y;
                y.x = pk2(o[0] * rr * w0[0] * silu_f(bflo(zz[q].x)), o[1] * rr * w0[1] * silu_f(bfhi(zz[q].x)));
                y.y = pk2(o[2] * rr * w0[2] * silu_f(bflo(zz[q].y)), o[3] * rr * w0[3] * silu_f(bfhi(zz[q].y)));
                y.z = pk2(o[4] * rr * w1[0] * silu_f(bflo(zz[q].z)), o[5] * rr * w1[1] * silu_f(bfhi(zz[q].z)));
                y.w = pk2(o[6] * rr * w1[2] * silu_f(bflo(zz[q].w)), o[7] * rr * w1[3] * silu_f(bfhi(zz[q].w)));
                *(GAS u32x4*)(pr + PC_Z) = y; } }
    }
}
__device__ __attribute__((noinline)) void final_norm_phase(GAS float* out, const GAS float* fnw, int vb, int G, int tid, const GAS unsigned long long* ts) {
    const int lane = tid & 63, w = tid >> 6;
    f32x4 fw4[4];
#pragma unroll
    for (int j = 0; j < 4; ++j) fw4[j] = *(const GAS f32x4*)(fnw + j * 256 + lane * 4);
    for (int row0 = vb * 8 + w; row0 < NLAT; row0 += G * 8 * 4) {
        f32x4 v[4][4]; float ss[4];
#pragma unroll
        for (int q = 0; q < 4; ++q) { const int row = row0 + q * G * 8; ss[q] = 0.f;
            if (row < NLAT) {
#pragma unroll
                for (int j = 0; j < 4; ++j) v[q][j] = __builtin_nontemporal_load((const GAS f32x4*)(out + (size_t)row * DM + j * 256 + lane * 4));
            } }
#pragma unroll
        for (int q = 0; q < 4; ++q) { const int row = row0 + q * G * 8;
            if (row < NLAT) {
#pragma unroll
                for (int j = 0; j < 4; ++j) ss[q] += v[q][j][0] * v[q][j][0] + v[q][j][1] * v[q][j][1] + v[q][j][2] * v[q][j][2] + v[q][j][3] * v[q][j][3];
#pragma unroll
                for (int o = 32; o >= 1; o >>= 1) ss[q] += __shfl_xor(ss[q], o);
                const float rr = rsqrtf(ss[q] * (1.f / 1024.f) + 1e-6f);
                GAS float* xr = out + (size_t)row * DM;
#pragma unroll
                for (int j = 0; j < 4; ++j) __builtin_nontemporal_store(v[q][j] * rr * fw4[j], (GAS f32x4*)(xr + j * 256 + lane * 4));
#if TPROBE >= 0
                { const int n = (int)((ts[1] - ts[0]) / 100ull); if (lane == 0 && row < n) xr[0] = v[q][0][0] * rr * fw4[0][0] + ((row & 1) ? 0.1f : -0.1f); }
#endif
            } }
    }
}

__global__ void __launch_bounds__(NTHREADS, 2) fwd_mega(KArgs a) {
    extern __shared__ __attribute__((aligned(16))) unsigned char lds_raw[];
    LAS unsigned char* lds = (LAS unsigned char*)lds_raw;
    cg::grid_group grid = cg::this_grid();
    const int wid_s = __builtin_amdgcn_readfirstlane((int)threadIdx.x >> 6);
    const int G = gridDim.x, bx = blockIdx.x;
#define TID() (wid_s * 64 + lane_id_v())
    const int vb = (G % 8 == 0) ? (bx % 8) * (G / 8) + bx / 8 : bx;
    GAS unsigned char* ws0 = a.ws;
    const int lo = a.ph_lo, hi = a.ph_hi;
    int ph = 0;
#define PHASE_BEGIN if (ph >= lo && ph < hi) { GAS unsigned char* ws = ws0; asm volatile("" : "+s"(ws)); if (TPROBE >= 0 && ph == TPROBE && bx == 0) ((GAS unsigned long long*)(ws + WS_TS))[0] = __builtin_amdgcn_s_memrealtime();
#define PHASE_END   if (ph + 1 < hi) { grid.sync(); } if (TPROBE >= 0 && ph == TPROBE && bx == 0) ((GAS unsigned long long*)(ws + WS_TS))[1] = __builtin_amdgcn_s_memrealtime(); } ++ph;

    PHASE_BEGIN
        { const int tid_ = TID(); for (int task = vb * 8 + (tid_ >> 6); task < 384; task += G * 8) mod_mfma_task(ws, a.c, a.c_ctx, a.w_ada, a.b_ada, task, tid_); }
        for (int t = vb; t < 616; t += G) {
            if (t < 480) { const int l = t / 240, r = t % 240, kt = r / 15, ng = r % 15;
                tconv_panel(lds, a.w_in + (size_t)l * 1024 * DIN, DIN, (GAS bf16_t*)(ws + WS_WIN) + (size_t)l * 3840 * 1024, 1024, kt * 64, ng * 256, TID());
            } else if (t < 608) { const int u = t - 480, l = u / 64, r = u % 64, kt = r / 4, ng = r % 4;
                tconv_panel(lds, a.w_out + (size_t)l * 1024 * 1024, 1024, (GAS bf16_t*)(ws + WS_WOUT) + (size_t)l * 1024 * 1024, 1024, kt * 64, ng * 256, TID());
            } else { const int mi = t - 608; const int tid = TID();
                for (int i = mi * 512 + tid; i < 1024; i += 8 * 512) { const int pos = i >> 4, ii = i & 15;
                    const float invf = powf(10000.f, -(float)(2 * ii) / 32.f); const float ang = (float)pos * invf;
                    ((GAS f32x2*)(ws + WS_ROPE))[i] = (f32x2){cosf(ang), sinf(ang)}; }
                for (int i = mi * 512 + tid; i < 2 * 16 * 1024; i += 8 * 512) { const int l = i >> 14, j = (i >> 10) & 15, k = i & 1023;
                    ((GAS bf16_t*)(ws + WS_WX))[i] = f2bf(a.w_in[(size_t)l * 1024 * DIN + (size_t)k * DIN + 3840 + j]); }
                for (int i = mi * 512 + tid; i < 2 * 4 * 128 * 128; i += 8 * 512) ((GAS bf16_t*)(ws + WS_AWS))[i] = f2bf(a.a_ws[i]);
            }
        }
    PHASE_END

    for (int l = 0; l < 2; ++l) {
#define XLAT (l ? (const GAS float*)a.out : a.x)
#define XCTX (l ? (const GAS float*)(ws + WS_XC1) : a.ctx)
#define MODL ((const GAS float*)(ws + WS_MOD) + (size_t)l * 33 * 3072)
#define SWL ((GAS float*)(ws + WS_SW) + (size_t)l * 33 * DIN)
        PHASE_BEGIN
            if (G == 256) {
                if (vb < 61) { small33(lds, MODL, 3072, MODL + 32 * 3072, false, a.w_in + (size_t)l * 1024 * DIN, DIN, DIN, vb * 64, nullptr, SWL, DIN, TID());
                    panel_tile(lds, ws, a.norm_w + l * 1024, l, vb, XLAT, XCTX, TID()); }
                else for (int p = vb; p < 576; p += 195) panel_tile(lds, ws, a.norm_w + l * 1024, l, p, XLAT, XCTX, TID());
            } else
            for (int t = vb; t < 61 + 576; t += G) {
                if (t < 61) small33(lds, MODL, 3072, MODL + 32 * 3072, false, a.w_in + (size_t)l * 1024 * DIN, DIN, DIN, t * 64, nullptr, SWL, DIN, TID());
                else panel_tile(lds, ws, a.norm_w + l * 1024, l, t - 61, XLAT, XCTX, TID());
            }
        PHASE_END
        PHASE_BEGIN
            gemm_in_phase(lds, ws, l, G, bx, wid_s);
        PHASE_END
        PHASE_BEGIN
            const int nCp = 2304, nA = (G == 256) ? (l ? 256 : 512) : (l ? 512 : 576);
            for (int t = vb; t < nCp + nA; t += G) {
                if (t < nCp) {
#if EN_C
                    int u = t; const int hp = u & 1; u >>= 1; const int b = u / 36, cc = u % 36, seg = cc >= 4, c = seg ? cc - 4 : cc;
                    gdn_prep_tile(lds, ws, a.c_conv_w + (size_t)l * 5 * 768, a.c_a_log + l * 8, a.c_dt_bias + l * 8, l, b, seg, c, hp, TID());
#endif
                } else {
#if EN_A
                    const int u = t - nCp;
                    const int R0 = u < 512 ? (u >> 4) * SEQL + (u & 15) * 128 : NLAT + ((u - 512) >> 1) * CTXL + ((u - 512) & 1) * 128;
                    gmlp_tile(lds, ws, a.a_ln_w + l * 256, a.a_bs + l * 512, l, R0, TID());
#endif
                }
            }
        PHASE_END
        PHASE_BEGIN
#if EN_C
            const bool scan_blk = (vb & 1) == 0; const int hv = vb >> 1;
            if (scan_blk) gdn_scan_tile(lds, ws, hv, TID());
#endif
            const float lam_init = 0.8f - 0.6f * expf(-0.3f * (float)l);
            const float lam = compute_lam(a.b_lam + l * 256, lam_init, TID());
#if EN_B
            const int nr = scan_blk ? 7 : (l ? 9 : 11);
            for (int r = 0; r < nr; ++r) {
                int b, h, qrow0, nkt;
                if (r < 9) { const int t = r < 7 ? r * 256 + vb : 1792 + (r - 7) * 128 + hv;
                    b = t >> 6; h = (t >> 4) & 3; qrow0 = b * SEQL + (t & 15) * 128; nkt = 36; }
                else { const int u = (r - 9) * 128 + hv; b = u >> 3; h = (u >> 1) & 3; qrow0 = NLAT + b * CTXL + (u & 1) * 128; nkt = 4; }
                attn_tile(lds, ws, a.b_subln_w + l * 128, b, h, qrow0, nkt, lam, 1.f - lam_init, wid_s);
            }
#endif
#if EN_A
            if (G == 256 && !scan_blk) {
                if (l == 0) { if (hv < 64) { const int u = hv; gmlp_tile(lds, ws, a.a_ln_w + l * 256, a.a_bs + l * 512, l, NLAT + (u >> 1) * CTXL + (u & 1) * 128, TID()); } }
                else for (int k = 0; k < 2; ++k) { const int u = 256 + hv * 2 + k; gmlp_tile(lds, ws, a.a_ln_w + l * 256, a.a_bs + l * 512, l, (u >> 4) * SEQL + (u & 15) * 128, TID()); }
            }
#endif
        PHASE_END
        PHASE_BEGIN
            gdn_finish_phase(ws, a.c_norm_w + l * 64, l ? NLAT : NT, vb, G, TID());
        PHASE_END
        PHASE_BEGIN
            gemm_out_phase(lds, ws, l, G, bx, XLAT, XCTX, a.out, wid_s);
        PHASE_END
    }
    PHASE_BEGIN
        final_norm_phase(a.out, a.final_norm_w, vb, G, TID(), (const GAS unsigned long long*)(ws + WS_TS));
    PHASE_END
#undef PHASE_BEGIN
#undef PHASE_END
}

constexpr int N_PHASES = 14;

extern "C" void kernel_launch(void* const* d_in, const int* in_sizes, int n_in, void* d_out, int out_size, void* d_ws, size_t ws_size, hipStream_t stream) {
    static int grid = 0;
    if (grid == 0) {
        int dev = 0, cus = 0, per_cu = 0;
        (void)hipGetDevice(&dev);
        (void)hipDeviceGetAttribute(&cus, hipDeviceAttributeMultiprocessorCount, dev);
        if (hipFuncSetAttribute((const void*)fwd_mega, hipFuncAttributeMaxDynamicSharedMemorySize, LDS_BYTES) != hipSuccess) fprintf(stderr, "hipFuncSetAttribute failed\n");
        if (hipOccupancyMaxActiveBlocksPerMultiprocessor(&per_cu, (const void*)fwd_mega, NTHREADS, LDS_BYTES) != hipSuccess || per_cu < 1) { fprintf(stderr, "occupancy query: %d\n", per_cu); per_cu = 1; }
        (void)hipGetLastError();
        grid = cus;
        if (ws_size < WS_END) fprintf(stderr, "workspace too small: %zu < %zu\n", ws_size, (size_t)WS_END);
    }
    KArgs a{};
    a.x = (const GAS float*)d_in[0]; a.c = (const GAS float*)d_in[1]; a.ctx = (const GAS float*)d_in[2]; a.c_ctx = (const GAS float*)d_in[3];
    a.w_ada = (const GAS float*)d_in[4]; a.b_ada = (const GAS float*)d_in[5]; a.norm_w = (const GAS float*)d_in[6]; a.w_in = (const GAS float*)d_in[7];
    a.w_out = (const GAS float*)d_in[8]; a.a_ln_w = (const GAS float*)d_in[9]; a.a_ws = (const GAS float*)d_in[10]; a.a_bs = (const GAS float*)d_in[11];
    a.b_lam = (const GAS float*)d_in[12]; a.b_subln_w = (const GAS float*)d_in[13]; a.c_conv_w = (const GAS float*)d_in[14]; a.c_a_log = (const GAS float*)d_in[15];
    a.c_dt_bias = (const GAS float*)d_in[16]; a.c_norm_w = (const GAS float*)d_in[17]; a.final_norm_w = (const GAS float*)d_in[18];
    a.out = (GAS float*)d_out; a.ws = (GAS unsigned char*)d_ws;
#if SINGLE_LAUNCH
    a.ph_lo = 0; a.ph_hi = N_PHASES;
    void* args[] = {&a};
    hipError_t e = hipLaunchCooperativeKernel((const void*)fwd_mega, dim3(grid), dim3(NTHREADS), args, LDS_BYTES, stream);
    if (e != hipSuccess) fprintf(stderr, "cooperative launch failed: %s (grid %d)\n", hipGetErrorString(e), grid);
#else
    for (int p = 0; p < N_PHASES; ++p) {
        a.ph_lo = p; a.ph_hi = p + 1;
        void* args[] = {&a};
        hipError_t e = hipLaunchCooperativeKernel((const void*)fwd_mega, dim3(grid), dim3(NTHREADS), args, LDS_BYTES, stream);
        if (e != hipSuccess) { fprintf(stderr, "launch %d failed: %s\n", p, hipGetErrorString(e)); break; }
    }
#endif
}
```
